# Optimizing an MI355X kernel written in HIP

```python
import math
import jax
import jax.numpy as jnp
from jax import lax
import numpy as np

D_MODEL = 1024
BATCH = 16
SEQ = 2048
DEPTH = 2

GRID_W = 64
CTX_LEN = 256
N_MIXERS = 4
GROUP_W = D_MODEL // N_MIXERS
D_MIX = N_MIXERS * GROUP_W
NORM_EPS = 1e-6
ROPE_THETA = 10000.0
Q_BLOCK = 128

RW_HD = 64
RW_HEADS = GROUP_W // RW_HD
D_DECAY_LORA = 64
D_AAA_LORA = 64
D_GATE_LORA = 128
RW_LN_EPS = 64e-5
RW_SPLITS = (GROUP_W, GROUP_W, GROUP_W, D_DECAY_LORA, D_DECAY_LORA, D_AAA_LORA, D_AAA_LORA, D_GATE_LORA)
RW_IN = 3 * GROUP_W + 2 * D_DECAY_LORA + 2 * D_AAA_LORA + D_GATE_LORA

DA_HD = 32
DA_VD = 2 * DA_HD
DA_HEADS = GROUP_W // DA_VD
DA_IN = 3 * GROUP_W

GLA_DV = 64
GLA_HEADS = GROUP_W // GLA_DV
GLA_DK = GLA_DV // 2
GLA_KW = GLA_HEADS * GLA_DK
GLA_GATE_RANK = 16
GLA_TAU = 16.0
GLA_CHUNK = 64
GLA_SPLITS = (GLA_KW, GLA_KW, GROUP_W, GLA_GATE_RANK, GLA_GATE_RANK, GROUP_W)
GLA_IN = 2 * GLA_KW + 2 * GROUP_W + 2 * GLA_GATE_RANK

GQA_HD = 64
GQA_HEADS = GROUP_W // GQA_HD
GQA_KV_HEADS = 2
GQA_GROUP = GQA_HEADS // GQA_KV_HEADS
GQA_KVW = GQA_KV_HEADS * GQA_HD
GQA_SPLITS = (GROUP_W, GQA_KVW, GQA_KVW)
GQA_IN = GROUP_W + 2 * GQA_KVW

MIXER_IN = (RW_IN, DA_IN, GLA_IN, GQA_IN)
N_IN = RW_IN + DA_IN + GLA_IN + GQA_IN
D_FF = 2816

kernel_name = 'hybrid_parallel_heads_diffusion_block'


def _cumsplit(x, widths):
    return jnp.split(x, np.cumsum(widths)[:-1].tolist(), axis=-1)


def rms_norm(x, g, eps=NORM_EPS):
    xf = x.astype(jnp.float32)
    y = xf * lax.rsqrt(jnp.mean(xf * xf, axis=-1, keepdims=True) + eps)
    return (y * g.astype(jnp.float32)).astype(x.dtype)


def modulate(x, g, shift, scale):
    return rms_norm(x, g) * (1 + scale) + shift


def shift_prev(u):
    return jnp.pad(u[:, :-1], ((0, 0), (1, 0), (0, 0)))


def shift_next(u):
    return jnp.pad(u[:, 1:], ((0, 0), (0, 1), (0, 0)))


def axial_rope_tables(rows, head_dim):
    row = jnp.repeat(jnp.arange(rows, dtype=jnp.float32), GRID_W)
    col = jnp.tile(jnp.arange(GRID_W, dtype=jnp.float32), rows)
    n_freq = head_dim // 4
    inv = ROPE_THETA ** (-jnp.arange(n_freq, dtype=jnp.float32) / n_freq)
    ang = jnp.concatenate([row[:, None] * inv, col[:, None] * inv], axis=-1)
    return jnp.cos(ang), jnp.sin(ang)


def apply_rope(x, cos, sin):
    half = x.shape[-1] // 2
    shape = (1, x.shape[1]) + (1,) * (x.ndim - 3) + (half,)
    cos = cos.reshape(shape)
    sin = sin.reshape(shape)
    xf = x.astype(jnp.float32)
    x1, x2 = xf[..., :half], xf[..., half:]
    return jnp.concatenate([x1 * cos - x2 * sin, x2 * cos + x1 * sin], axis=-1).astype(x.dtype)


def sweep_query_blocks(fn, q):
    B, T = q.shape[:2]
    nb = T // Q_BLOCK
    qb = q.reshape((B, nb, Q_BLOCK) + q.shape[2:]).swapaxes(0, 1)
    ob = lax.map(fn, qb)
    return ob.swapaxes(0, 1).reshape((B, T) + ob.shape[3:])


def rwkv7_prepare(pa, mu, w0, w2, a0, a2, g2, k_k, k_a):
    B, T, _ = pa.shape
    pa = pa + mu[0] * (shift_prev(pa) - pa) + mu[1] * (shift_next(pa) - pa)
    r, k, v, wf, wb, af, ab, g = _cumsplit(pa, RW_SPLITS)
    hv = lambda t: t.reshape(B, T, RW_HEADS, RW_HD).astype(jnp.float32)
    out_gate = jax.nn.sigmoid(g) @ g2
    kk = hv(k * k_k)
    kk = kk * lax.rsqrt(jnp.sum(kk * kk, axis=-1, keepdims=True) + 1e-12)
    per_dir = []
    for d, (wd, ad) in enumerate(((wf, af), (wb, ab))):
        w_log = -jax.nn.softplus(-(w0[d] + jnp.tanh(wd) @ w2[d])) - 0.5
        decay = jnp.exp(-jnp.exp(w_log.astype(jnp.float32)))
        a = jax.nn.sigmoid(a0[d] + ad @ a2[d])
        kd = k * (1 + (a - 1) * k_a)
        per_dir.append((hv(decay), hv(kd), hv(a)))
    return hv(r), hv(v), kk, per_dir, out_gate


def rwkv7_scan(S0, r, decay, k, v, kk, a, reverse, with_outputs):
    seq = (decay, k, v, -kk, kk * a) + ((r,) if with_outputs else ())
    xs = tuple(jnp.moveaxis(t, 1, 0) for t in seq)

    def step(S, inp):
        w_t, k_t, v_t, a_t, b_t = inp[:5]
        sa = jnp.einsum('bhvk,bhk->bhv', S, a_t)
        S = S * w_t[:, :, None, :] + sa[..., None] * b_t[:, :, None, :] + v_t[..., None] * k_t[:, :, None, :]
        y = jnp.einsum('bhvk,bhk->bhv', S, inp[5]) if with_outputs else None
        return S, y

    S, ys = lax.scan(step, S0, xs, reverse=reverse)
    return S, (jnp.moveaxis(ys, 0, 1) if with_outputs else None)


def rwkv7_output(y, r, v, dirs, r_k, ln_g, ln_b, gate):
    B, T = y.shape[:2]
    mean = jnp.mean(y, axis=-1, keepdims=True)
    var = jnp.mean(jnp.square(y - mean), axis=-1, keepdims=True)
    yn = ((y - mean) * lax.rsqrt(var + RW_LN_EPS)).reshape(B, T, GROUP_W) * ln_g + ln_b
    bonus = sum(jnp.sum(r * kd * r_k, axis=-1, keepdims=True) * v for (_, kd, _) in dirs)
    return (yn + bonus.reshape(B, T, GROUP_W)) * gate


def rwkv7_mixer(pa_l, pa_c, mu, w0, w2, a0, a2, g2, k_k, k_a, r_k, ln_g, ln_b, need_ctx):
    r_l, v_l, kk_l, dirs_l, gate_l = rwkv7_prepare(pa_l, mu, w0, w2, a0, a2, g2, k_k, k_a)
    r_c, v_c, kk_c, dirs_c, gate_c = rwkv7_prepare(pa_c, mu, w0, w2, a0, a2, g2, k_k, k_a)
    B = pa_l.shape[0]
    y_l = 0.0
    y_c = 0.0
    for d in range(2):
        rev = d == 1
        dec_c, kd_c, a_c = dirs_c[d]
        S0 = jnp.zeros((B, RW_HEADS, RW_HD, RW_HD), jnp.float32)
        S_c, yc = rwkv7_scan(S0, r_c, dec_c, kd_c, v_c, kk_c, a_c, rev, need_ctx)
        dec_l, kd_l, a_l = dirs_l[d]
        _, yl = rwkv7_scan(S_c, r_l, dec_l, kd_l, v_l, kk_l, a_l, rev, True)
        y_l = y_l + yl
        if need_ctx:
            y_c = y_c + yc
    o_l = rwkv7_output(y_l, r_l, v_l, dirs_l, r_k, ln_g, ln_b, gate_l)
    o_c = rwkv7_output(y_c, r_c, v_c, dirs_c, r_k, ln_g, ln_b, gate_c) if need_ctx else None
    return o_l, o_c


def diff_attention_core(q, k, v, lam):
    s = jnp.einsum('bqhmd,bkhmd->bhmqk', q, k).astype(jnp.float32) * (DA_HD ** -0.5)
    p = jax.nn.softmax(s, axis=-1)
    att = p[:, :, 0] - lam * p[:, :, 1]
    return jnp.einsum('bhqk,bkhe->bqhe', att, v.astype(jnp.float32))


def diff_attention_mixer(pb_l, pb_c, qk_g, lam_vecs, subln_g, layer_idx, cos, sin, need_ctx):
    lam_init = 0.8 - 0.6 * math.exp(-0.3 * layer_idx)
    lv = lam_vecs.astype(jnp.float32)
    lam = jnp.exp(jnp.sum(lv[0] * lv[1])) - jnp.exp(jnp.sum(lv[2] * lv[3])) + lam_init

    def heads(p):
        B, T, _ = p.shape
        q, k, v = jnp.split(p, 3, axis=-1)
        q = rms_norm(q.reshape(B, T, DA_HEADS, 2, DA_HD), qk_g[0])
        k = rms_norm(k.reshape(B, T, DA_HEADS, 2, DA_HD), qk_g[1])
        return q, k, v.reshape(B, T, DA_HEADS, DA_VD)

    def finish(o):
        B, T = o.shape[:2]
        return (rms_norm(o, subln_g) * (1 - lam_init)).reshape(B, T, GROUP_W)

    q_l, k_l, v_l = heads(pb_l)
    q_c, k_c, v_c = heads(pb_c)
    q_l = apply_rope(q_l, cos, sin)
    k_l = apply_rope(k_l, cos, sin)
    k_all = jnp.concatenate([k_l, k_c], axis=1)
    v_all = jnp.concatenate([v_l, v_c], axis=1)
    o_l = finish(sweep_query_blocks(lambda qb: diff_attention_core(qb, k_all, v_all, lam), q_l))
    o_c = finish(diff_attention_core(q_c, k_c, v_c, lam)) if need_ctx else None
    return o_l, o_c


def gla_prepare(pc, a2, ab):
    B, T, _ = pc.shape
    q, k, v, gf, gb, r = _cumsplit(pc, GLA_SPLITS)
    hk = lambda t: t.reshape(B, T, GLA_HEADS, GLA_DK).astype(jnp.float32)
    q = hk(q) * (GLA_DK ** -0.5)
    k = hk(k)
    v = v.reshape(B, T, GLA_HEADS, GLA_DV).astype(jnp.float32)
    log_gates = [hk(jax.nn.log_sigmoid((g @ a2[d] + ab[d]).astype(jnp.float32)) / GLA_TAU)
                 for d, g in enumerate((gf, gb))]
    return q, k, v, log_gates, r


def gla_chunked(S0, k, v, lg, q=None):
    B, T, H, _ = k.shape
    nc = T // GLA_CHUNK
    chunks = lambda t: t.reshape(B, nc, GLA_CHUNK, H, t.shape[-1]).transpose(1, 0, 3, 2, 4)
    k, v, lg = chunks(k), chunks(v), chunks(lg)
    b = jnp.cumsum(lg, axis=3)
    b_end = b[:, :, :, -1:, :]
    k_end = k * jnp.exp(b_end - b)
    dec = jnp.exp(b_end[:, :, :, 0, :])
    if q is None:
        def step_state(S, inp):
            ke, vv, dd = inp
            return S * dd[..., None] + jnp.einsum('bhld,bhle->bhde', ke, vv), None
        S, _ = lax.scan(step_state, S0, (k_end, v, dec))
        return S, None
    q = chunks(q)
    q_in = q * jnp.exp(b)
    k_in = k * jnp.exp(-b)
    mask = jnp.tril(jnp.ones((GLA_CHUNK, GLA_CHUNK), dtype=bool))
    att = jnp.where(mask, jnp.einsum('cbhid,cbhjd->cbhij', q_in, k_in), 0.0)
    o_intra = jnp.einsum('cbhij,cbhje->cbhie', att, v)

    def step(S, inp):
        qi, ke, vv, dd = inp
        o = jnp.einsum('bhld,bhde->bhle', qi, S)
        return S * dd[..., None] + jnp.einsum('bhld,bhle->bhde', ke, vv), o

    S, o_inter = lax.scan(step, S0, (q_in, k_end, v, dec))
    o = (o_intra + o_inter).transpose(1, 0, 3, 2, 4).reshape(B, T, H, -1)
    return S, o


def gla_direction(S0, q, k, v, lg, reverse, with_outputs):
    flip = (lambda t: jnp.flip(t, axis=1)) if reverse else (lambda t: t)
    S, o = gla_chunked(S0, flip(k), flip(v), flip(lg), flip(q) if with_outputs else None)
    return S, (flip(o) if with_outputs else None)


def gla_mixer(pc_l, pc_c, a2, ab, norm_g, need_ctx):
    q_l, k_l, v_l, lg_l, r_l = gla_prepare(pc_l, a2, ab)
    q_c, k_c, v_c, lg_c, r_c = gla_prepare(pc_c, a2, ab)
    B = pc_l.shape[0]
    o_l = 0.0
    o_c = 0.0
    for d in range(2):
        S0 = jnp.zeros((B, GLA_HEADS, GLA_DK, GLA_DV), jnp.float32)
        S_c, oc = gla_direction(S0, q_c, k_c, v_c, lg_c[d], d == 1, need_ctx)
        _, ol = gla_direction(S_c, q_l, k_l, v_l, lg_l[d], d == 1, True)
        o_l = o_l + ol
        if need_ctx:
            o_c = o_c + oc

    def finish(o, r):
        B_, T = o.shape[:2]
        return rms_norm(o, norm_g).reshape(B_, T, GROUP_W) * jax.nn.silu(r)

    return finish(o_l, r_l), (finish(o_c, r_c) if need_ctx else None)


def gqa_core(q, k, v):
    s = jnp.einsum('bqhgd,bkhd->bhgqk', q, k).astype(jnp.float32) * (GQA_HD ** -0.5)
    p = jax.nn.softmax(s, axis=-1)
    return jnp.einsum('bhgqk,bkhd->bqhgd', p, v.astype(jnp.float32))


def gqa_mixer(pd_l, pd_c, qk_g, cos, sin, need_ctx):
    def heads(p):
        B, T, _ = p.shape
        q, k, v = _cumsplit(p, GQA_SPLITS)
        q = rms_norm(q.reshape(B, T, GQA_KV_HEADS, GQA_GROUP, GQA_HD), qk_g[0])
        k = rms_norm(k.reshape(B, T, GQA_KV_HEADS, GQA_HD), qk_g[1])
        return q, k, v.reshape(B, T, GQA_KV_HEADS, GQA_HD)

    q_l, k_l, v_l = heads(pd_l)
    q_c, k_c, v_c = heads(pd_c)
    q_l = apply_rope(q_l, cos, sin)
    k_l = apply_rope(k_l, cos, sin)
    k_all = jnp.concatenate([k_l, k_c], axis=1)
    v_all = jnp.concatenate([v_l, v_c], axis=1)
    B, T = pd_l.shape[:2]
    o_l = sweep_query_blocks(lambda qb: gqa_core(qb, k_all, v_all), q_l).reshape(B, T, GROUP_W)
    o_c = gqa_core(q_c, k_c, v_c).reshape(B, pd_c.shape[1], GROUP_W) if need_ctx else None
    return o_l, o_c


def conv_ffn(h, w_up, conv_w, conv_b, w_down):
    u, g = jnp.split(h @ w_up, 2, axis=-1)
    g = conv_w[0] * shift_prev(g) + conv_w[1] * g + conv_w[2] * shift_next(g) + conv_b
    return (jax.nn.silu(g) * u) @ w_down


def setup_inputs(seed: int = 0) -> dict:
    key = jax.random.key(seed)
    ks = iter(jax.random.split(key, 40))
    nrm = lambda shape, s: jax.random.normal(next(ks), shape, jnp.float32) * s
    L = DEPTH
    D = D_MODEL
    return {
        'x': nrm((BATCH, SEQ, D), 1.0),
        'c': nrm((BATCH, D), 1.0),
        'ctx': nrm((BATCH, CTX_LEN, D), 1.0),
        'c_ctx': nrm((D,), 1.0),
        'mod_w': nrm((L, D, 6 * D), 0.3 * D ** -0.5),
        'mod_b': nrm((L, 6 * D), 0.02),
        'norm_mix_g': 1.0 + nrm((L, D), 0.05),
        'norm_ffn_g': 1.0 + nrm((L, D), 0.05),
        'w_in': nrm((L, D, N_IN), D ** -0.5),
        'w_out': nrm((L, D_MIX, D), D_MIX ** -0.5),
        'rw_mu': jax.random.uniform(next(ks), (L, 2, RW_IN), jnp.float32, 0.0, 0.5),
        'rw_w0': nrm((L, 2, GROUP_W), 1.0) - 2.0,
        'rw_w2': nrm((L, 2, D_DECAY_LORA, GROUP_W), 0.5 * D_DECAY_LORA ** -0.5),
        'rw_a0': nrm((L, 2, GROUP_W), 0.5),
        'rw_a2': nrm((L, 2, D_AAA_LORA, GROUP_W), 0.5 * D_AAA_LORA ** -0.5),
        'rw_g2': nrm((L, D_GATE_LORA, GROUP_W), D_GATE_LORA ** -0.5),
        'rw_kk': 0.85 + nrm((L, GROUP_W), 0.05),
        'rw_ka': 1.0 + nrm((L, GROUP_W), 0.05),
        'rw_rk': nrm((L, RW_HEADS, RW_HD), 0.1),
        'rw_ln_g': 1.0 + nrm((L, GROUP_W), 0.05),
        'rw_ln_b': nrm((L, GROUP_W), 0.02),
        'da_qk_g': 1.0 + nrm((L, 2, DA_HD), 0.05),
        'da_lam': nrm((L, 4, DA_HD), 0.1),
        'da_subln_g': 1.0 + nrm((L, DA_VD), 0.05),
        'gla_a2': nrm((L, 2, GLA_GATE_RANK, GLA_KW), GLA_GATE_RANK ** -0.5),
        'gla_ab': nrm((L, 2, GLA_KW), 0.5),
        'gla_norm_g': 1.0 + nrm((L, GLA_DV), 0.05),
        'gqa_qk_g': 1.0 + nrm((L, 2, GQA_HD), 0.05),
        'ffn_w_up': nrm((L, D, 2 * D_FF), D ** -0.5),
        'ffn_conv_w': nrm((L, 3, D_FF), 0.6),
        'ffn_conv_b': nrm((L, D_FF), 0.02),
        'ffn_w_down': nrm((L, D_FF, D), D_FF ** -0.5),
    }


def reference(x, c, ctx, c_ctx, mod_w, mod_b, norm_mix_g, norm_ffn_g, w_in, w_out,
              rw_mu, rw_w0, rw_w2, rw_a0, rw_a2, rw_g2, rw_kk, rw_ka, rw_rk, rw_ln_g, rw_ln_b,
              da_qk_g, da_lam, da_subln_g, gla_a2, gla_ab, gla_norm_g, gqa_qk_g,
              ffn_w_up, ffn_conv_w, ffn_conv_b, ffn_w_down):
    n_lat = x.shape[1]
    rows = n_lat // GRID_W
    cos_da, sin_da = axial_rope_tables(rows, DA_HD)
    cos_gq, sin_gq = axial_rope_tables(rows, GQA_HD)
    xc = ctx
    for i in range(DEPTH):
        need_ctx = i < DEPTH - 1
        mod_l = [m[:, None, :] for m in jnp.split(jax.nn.silu(c) @ mod_w[i] + mod_b[i], 6, axis=-1)]
        mod_c = jnp.split(jax.nn.silu(c_ctx) @ mod_w[i] + mod_b[i], 6, axis=-1)
        h_l = modulate(x, norm_mix_g[i], mod_l[0], mod_l[1])
        h_c = modulate(xc, norm_mix_g[i], mod_c[0], mod_c[1])
        pa_l, pb_l, pc_l, pd_l = _cumsplit(h_l @ w_in[i], MIXER_IN)
        pa_c, pb_c, pc_c, pd_c = _cumsplit(h_c @ w_in[i], MIXER_IN)
        oa_l, oa_c = rwkv7_mixer(pa_l, pa_c, rw_mu[i], rw_w0[i], rw_w2[i], rw_a0[i], rw_a2[i], rw_g2[i],
                                 rw_kk[i], rw_ka[i], rw_rk[i], rw_ln_g[i], rw_ln_b[i], need_ctx)
        ob_l, ob_c = diff_attention_mixer(pb_l, pb_c, da_qk_g[i], da_lam[i], da_subln_g[i], i,
                                          cos_da, sin_da, need_ctx)
        oc_l, oc_c = gla_mixer(pc_l, pc_c, gla_a2[i], gla_ab[i], gla_norm_g[i], need_ctx)
        od_l, od_c = gqa_mixer(pd_l, pd_c, gqa_qk_g[i], cos_gq, sin_gq, need_ctx)
        o_l = jnp.concatenate([oa_l, ob_l, oc_l, od_l], axis=-1).astype(x.dtype)
        x = x + mod_l[2] * (o_l @ w_out[i])
        if need_ctx:
            o_c = jnp.concatenate([oa_c, ob_c, oc_c, od_c], axis=-1).astype(xc.dtype)
            xc = xc + mod_c[2] * (o_c @ w_out[i])
        x = x + mod_l[5] * conv_ffn(modulate(x, norm_ffn_g[i], mod_l[3], mod_l[4]),
                                    ffn_w_up[i], ffn_conv_w[i], ffn_conv_b[i], ffn_w_down[i])
        if need_ctx:
            xc = xc + mod_c[5] * conv_ffn(modulate(xc, norm_ffn_g[i], mod_c[3], mod_c[4]),
                                          ffn_w_up[i], ffn_conv_w[i], ffn_conv_b[i], ffn_w_down[i])
    return x
```

```cpp
#include <hip/hip_runtime.h>
#include <hip/hip_bf16.h>
#include <hip/hip_cooperative_groups.h>
#include <cstdio>
namespace cg = cooperative_groups;

#define DI __device__ __forceinline__
#define DN __device__ __forceinline__
#define LAS __attribute__((address_space(3)))
extern __shared__ __attribute__((aligned(16))) unsigned char dynlds[];
constexpr int LDS_RING = 131072, LDS_BD_OFF = 131072, LDS_MISC_OFF = 131072 + 4096, LDS_PARAMS_OFF = 131072 + 4096 + 256, LDS_BYTES = 131072 + 4096 + 256 + 512;
DI int otid() { int t = threadIdx.x & 255; asm volatile("" : "+v"(t)); return t; }
DI int oidx(int i) { asm volatile("" : "+s"(i)); return i; }
DI int vhalf() { int h = __builtin_amdgcn_readfirstlane(threadIdx.x >> 8); asm volatile("" : "+s"(h)); return h; }
DI int VB() { return blockIdx.x * 2 + vhalf(); }
DI int NVB() { return gridDim.x * 2; }
DI void vsync() {
  __builtin_amdgcn_fence(__ATOMIC_RELEASE, "workgroup");
  if ((threadIdx.x & 63) == 0) {
    int* bar = (int*)(dynlds + LDS_MISC_OFF) + (threadIdx.x >> 8);
    int old = __hip_atomic_fetch_add(bar, 1, __ATOMIC_RELAXED, __HIP_MEMORY_SCOPE_WORKGROUP);
    int tgt = (old & ~3) + 4;
    while (__hip_atomic_load(bar, __ATOMIC_RELAXED, __HIP_MEMORY_SCOPE_WORKGROUP) - tgt < 0) __builtin_amdgcn_s_sleep(1);
  }
  __builtin_amdgcn_fence(__ATOMIC_ACQUIRE, "workgroup");
}
typedef unsigned short bfr;
typedef __attribute__((ext_vector_type(8))) short bf16x8;
typedef __attribute__((ext_vector_type(4))) short s16x4;
typedef __attribute__((ext_vector_type(16))) float f32x16;
typedef __attribute__((ext_vector_type(4))) unsigned u32x4;
typedef __attribute__((ext_vector_type(2))) float f32x2;
typedef __attribute__((ext_vector_type(4))) float f32x4v;
#define MFMA32(a, b, c) __builtin_amdgcn_mfma_f32_32x32x16_bf16((a), (b), (c), 0, 0, 0)

constexpr int NB = 16, TL = 2048, TC = 256, TT = 2304, DM = 1024, MR = NB * TT;
constexpr int PW = 3264, NINP = 3328, DFF = 2816;
constexpr int SMEM_BYTES = 55296;

constexpr size_t OFF_WIN = 0;
constexpr size_t SZ_WIN = (size_t)NINP * DM * 2;
constexpr size_t OFF_WOUT = OFF_WIN + SZ_WIN;
constexpr size_t SZ_WOUT = (size_t)DM * DM * 2;
constexpr size_t OFF_WUP = OFF_WOUT + SZ_WOUT;
constexpr size_t SZ_WUP = (size_t)2 * DFF * DM * 2;
constexpr size_t OFF_WDN = OFF_WUP + SZ_WUP;
constexpr size_t SZ_WDN = (size_t)DM * DFF * 2;
constexpr size_t OFF_WLORA = OFF_WDN + SZ_WDN;
constexpr size_t SZ_WLORA = (size_t)1280 * 384 * 2;
constexpr size_t OFF_MOD = OFF_WLORA + SZ_WLORA;
constexpr size_t SZ_MOD = (size_t)2 * 17 * 6144 * 4;
constexpr size_t OFF_XC = OFF_MOD + SZ_MOD;
constexpr size_t SZ_XC = (size_t)NB * TC * DM * 4;
constexpr size_t OFF_ROPE = OFF_XC + SZ_XC;
constexpr size_t SZ_ROPE = (size_t)TL * 96 * 4;
constexpr size_t OFF_CTR = OFF_ROPE + SZ_ROPE;
constexpr size_t SZ_CTR = 256;
constexpr size_t OFF_HO = OFF_CTR + SZ_CTR;
constexpr size_t SZ_HO = (size_t)MR * DM * 2;
constexpr size_t OFF_P = OFF_HO + SZ_HO;
constexpr size_t SZ_P = (size_t)MR * PW * 2;
constexpr size_t OFF_RWIN = OFF_P + SZ_P;
constexpr size_t SZ_RWIN = (size_t)5 * MR * 256 * 2;
constexpr size_t OFF_RWY = OFF_RWIN + SZ_RWIN;
constexpr size_t SZ_RWY = (size_t)2 * MR * 256 * 2;
constexpr size_t OFF_GS = OFF_RWY + SZ_RWY;
constexpr size_t SZ_GS = (size_t)NB * 36 * 4 * 2 * 2048 * 4;
constexpr size_t WS_TOTAL = OFF_GS + SZ_GS;
static_assert(WS_TOTAL <= (size_t)536870912, "workspace too large");
constexpr size_t OFF_A2 = OFF_P;
constexpr size_t OFF_EDGE = OFF_RWIN;

struct Params {
  const float* in[32];
  float* out;
  char* ws;
};

DI void vsync_l() {
  asm volatile("s_waitcnt lgkmcnt(0)" ::: "memory");
  if ((threadIdx.x & 63) == 0) {
    int* bar = (int*)(dynlds + LDS_MISC_OFF) + (threadIdx.x >> 8);
    int old = __hip_atomic_fetch_add(bar, 1, __ATOMIC_RELAXED, __HIP_MEMORY_SCOPE_WORKGROUP);
    int tgt = (old & ~3) + 4;
    while (__hip_atomic_load(bar, __ATOMIC_RELAXED, __HIP_MEMORY_SCOPE_WORKGROUP) - tgt < 0) __builtin_amdgcn_s_sleep(1);
  }
  asm volatile("" ::: "memory");
}
DI bfr f2bf(float x) { unsigned u = __float_as_uint(x); u += 0x7fffu + ((u >> 16) & 1u); return (bfr)(u >> 16); }
DI float bf2f(bfr u) { return __uint_as_float(((unsigned)u) << 16); }
DI unsigned pack2(float a, float b) { unsigned r; asm volatile("v_cvt_pk_bf16_f32 %0, %1, %2" : "=v"(r) : "v"(a), "v"(b)); return r; }
template <int CTRL> DI float dppf(float x) {
  return __builtin_bit_cast(float, __builtin_amdgcn_mov_dpp(__builtin_bit_cast(int, x), CTRL, 0xf, 0xf, true));
}
DI float wave_sum(float v) {
  v += dppf<0xB1>(v); v += dppf<0x4E>(v); v += dppf<0x141>(v); v += dppf<0x140>(v);
  const float r0 = __builtin_bit_cast(float, __builtin_amdgcn_readlane(__builtin_bit_cast(int, v), 0));
  const float r1 = __builtin_bit_cast(float, __builtin_amdgcn_readlane(__builtin_bit_cast(int, v), 16));
  const float r2 = __builtin_bit_cast(float, __builtin_amdgcn_readlane(__builtin_bit_cast(int, v), 32));
  const float r3 = __builtin_bit_cast(float, __builtin_amdgcn_readlane(__builtin_bit_cast(int, v), 48));
  return (r0 + r1) + (r2 + r3);
}
DI float red8(float x) { x += dppf<0xB1>(x); x += dppf<0x4E>(x); x += dppf<0x141>(x); return x; }
DI float sigmoidf_(float x) { return 1.f / (1.f + expf(-x)); }
DI float softplusf_(float z) { return fmaxf(z, 0.f) + log1pf(expf(-fabsf(z))); }

DI const float* in_row(const Params& p, int b, int t) {
  return t < TL ? p.in[oidx(0)] + ((size_t)b * TL + t) * DM : p.in[oidx(2)] + ((size_t)b * TC + (t - TL)) * DM;
}
DI float* res_row(const Params& p, int b, int t) {
  return t < TL ? p.out + ((size_t)b * TL + t) * DM : (float*)(p.ws + OFF_XC) + ((size_t)b * TC + (t - TL)) * DM;
}

DN void convert_weights(const Params& p, int l, char* smem) {
  float* tile68 = (float*)smem;
  const int tid = otid();
  const int T_IN = 52 * 16, T_OUT = 16 * 16, T_UP = 88 * 16, T_DN = 16 * 44;
  const int total = T_IN + T_OUT + T_UP + T_DN;
  for (int it = VB(); it < total; it += NVB()) {
    const float* src; int ld, ldd, n0, k0, mode, nvalid; bfr* dst;
    if (it < T_IN) { int nt = it / 16, kt = it % 16; src = p.in[oidx(8)] + (size_t)l * DM * 3232; ld = 3232; nvalid = 3232; dst = (bfr*)(p.ws + OFF_WIN); ldd = DM; n0 = nt * 64; k0 = kt * 64; mode = 0; }
    else if (it < T_IN + T_OUT) { int i2 = it - T_IN; int nt = i2 / 16, kt = i2 % 16; src = p.in[oidx(9)] + (size_t)l * DM * DM; ld = DM; nvalid = DM; dst = (bfr*)(p.ws + OFF_WOUT); ldd = DM; n0 = nt * 64; k0 = kt * 64; mode = 0; }
    else if (it < T_IN + T_OUT + T_UP) { int i2 = it - T_IN - T_OUT; int nt = i2 / 16, kt = i2 % 16; src = p.in[oidx(28)] + (size_t)l * DM * 2 * DFF; ld = 2 * DFF; nvalid = 2 * DFF; dst = (bfr*)(p.ws + OFF_WUP); ldd = DM; n0 = nt * 64; k0 = kt * 64; mode = 1; }
    else { int i2 = it - T_IN - T_OUT - T_UP; int nt = i2 / 44, kt = i2 % 44; src = p.in[oidx(31)] + (size_t)l * DFF * DM; ld = DM; nvalid = DM; dst = (bfr*)(p.ws + OFF_WDN); ldd = DFF; n0 = nt * 64; k0 = kt * 64; mode = 0; }
#pragma unroll
    for (int i = 0; i < 4; ++i) {
      const int c = tid + 256 * i, kl = c >> 4, n4 = (c & 15) * 4;
      const int n = n0 + n4;
      int sc = n;
      if (mode == 1) { int grp = n >> 8, within = n & 255; sc = ((within >= 128) ? DFF : 0) + grp * 128 + (within & 127); }
      f32x4v v = {0.f, 0.f, 0.f, 0.f};
      if (sc < nvalid) v = *(const f32x4v*)(src + (size_t)(k0 + kl) * ld + sc);
      *(f32x4v*)(&tile68[kl * 68 + n4]) = v;
    }
    vsync();
#pragma unroll
    for (int i = 0; i < 2; ++i) {
      const int c = tid + 256 * i, nl = c & 63, k8 = (c >> 6) * 8;
      float t8[8];
#pragma unroll
      for (int e = 0; e < 8; ++e) t8[e] = tile68[(k8 + e) * 68 + nl];
      u32x4 ow; ow.x = pack2(t8[0], t8[1]); ow.y = pack2(t8[2], t8[3]); ow.z = pack2(t8[4], t8[5]); ow.w = pack2(t8[6], t8[7]);
      *(u32x4*)(dst + (size_t)(n0 + nl) * ldd + k0 + k8) = ow;
    }
    vsync();
  }
  {
    bfr* WL = (bfr*)(p.ws + OFF_WLORA);
    const float* w2 = p.in[oidx(12)] + (size_t)l * 2 * 64 * 256;
    const float* a2 = p.in[oidx(14)] + (size_t)l * 2 * 64 * 256;
    const float* g2 = p.in[oidx(15)] + (size_t)l * 128 * 256;
    for (int i = VB() * 256 + tid; i < 1280 * 384; i += NVB() * 256) {
      int n = i / 384, k = i - n * 384;
      int kind = n >> 8, c = n & 255;
      float v = 0.f;
      if (kind < 4) { int kb = k - kind * 64; if (kb >= 0 && kb < 64 && k < 256) v = (kind < 2) ? w2[((size_t)kind * 64 + kb) * 256 + c] : a2[((size_t)(kind - 2) * 64 + kb) * 256 + c]; }
      else { if (k >= 256) v = g2[(size_t)(k - 256) * 256 + c]; }
      WL[i] = f2bf(v);
    }
  }
}

DN void compute_mod(const Params& p, char* smem) {
  float* sc = (float*)smem;
  float* red = sc + 17 * 256;
  const int tid = otid();
  float* MOD = (float*)(p.ws + OFF_MOD);
  for (int it = VB(); it < 192; it += NVB()) {
    int l = it / 96, nb = it % 96;
    int col = nb * 64 + (tid & 63), kg = tid >> 6;
    const float* W = p.in[oidx(4)] + (size_t)l * DM * 6144;
    float acc[17];
#pragma unroll
    for (int r = 0; r < 17; ++r) acc[r] = 0.f;
    for (int kc = 0; kc < 4; ++kc) {
      vsync();
      for (int i = tid; i < 17 * 256; i += 256) {
        int r = i >> 8, k = i & 255;
        float c = (r < 16) ? p.in[oidx(1)][r * DM + kc * 256 + k] : p.in[oidx(3)][kc * 256 + k];
        sc[i] = c / (1.f + expf(-c));
      }
      vsync();
#pragma unroll 1
      for (int kk0 = 0; kk0 < 64; kk0 += 16) {
        float wv[16];
#pragma unroll
        for (int u = 0; u < 16; ++u) wv[u] = W[(size_t)(kc * 256 + kg * 64 + kk0 + u) * 6144 + col];
#pragma unroll
        for (int u = 0; u < 16; ++u) {
#pragma unroll
          for (int r = 0; r < 17; ++r) acc[r] += sc[r * 256 + kg * 64 + kk0 + u] * wv[u];
        }
      }
    }
    vsync();
#pragma unroll
    for (int r = 0; r < 17; ++r) red[(kg * 17 + r) * 64 + (tid & 63)] = acc[r];
    vsync();
    for (int i = tid; i < 17 * 64; i += 256) {
      int r = i >> 6, cl = i & 63;
      float s = red[(0 * 17 + r) * 64 + cl] + red[(1 * 17 + r) * 64 + cl] + red[(2 * 17 + r) * 64 + cl] + red[(3 * 17 + r) * 64 + cl];
      MOD[(size_t)(l * 17 + r) * 6144 + nb * 64 + cl] = s + p.in[oidx(5)][l * 6144 + nb * 64 + cl];
    }
  }
}

DN void compute_rope(const Params& p) {
  float* rope = (float*)(p.ws + OFF_ROPE);
  const int gtid = VB() * 256 + otid(), gsz = NVB() * 256;
  for (int i = gtid; i < TL * 48; i += gsz) {
    int t = i / 48, e = i % 48;
    int row = t >> 6, col = t & 63;
    int nf, idx;
    if (e < 16) { nf = 8; idx = e; } else { nf = 16; idx = e - 16; }
    int fi = idx % nf;
    float pos = (idx < nf) ? (float)row : (float)col;
    float inv = exp2f(-(float)fi / (float)nf * 13.287712379549449f);
    float ang = pos * inv;
    float cs = cosf(ang), sn = sinf(ang);
    if (e < 16) { rope[t * 96 + e] = cs; rope[t * 96 + 16 + e] = sn; }
    else { rope[t * 96 + 32 + idx] = cs; rope[t * 96 + 64 + idx] = sn; }
  }
}

DN void norm_phase(const Params& p, int l, int which, bool from_input, bool skip_ctx) {
  const int tid = otid(), lane = tid & 63;
  const int wave = (VB() * 256 + tid) >> 6, nw = NVB() * 4;
  const float* g = p.in[oidx(6) + which] + l * DM;
  const float* MOD = (const float*)(p.ws + OFF_MOD);
  bfr* H = (bfr*)(p.ws + OFF_HO);
  for (int m0 = wave * 4; m0 < MR; m0 += nw * 4) {
    f32x4v v[4][4];
    float ss[4];
    bool act[4];
    const float* modp[4];
#pragma unroll
    for (int q = 0; q < 4; ++q) {
      const int m = m0 + q;
      const int b = m / TT, t = m - b * TT;
      const bool isctx = t >= TL;
      act[q] = !(isctx && skip_ctx);
      const float* src = from_input ? in_row(p, b, t) : res_row(p, b, t);
      modp[q] = MOD + (size_t)(l * 17 + (isctx ? 16 : b)) * 6144;
      ss[q] = 0.f;
      if (act[q]) {
#pragma unroll
        for (int i = 0; i < 4; ++i) {
          v[q][i] = *(const f32x4v*)(src + i * 256 + lane * 4);
          ss[q] += v[q][i].x * v[q][i].x + v[q][i].y * v[q][i].y + v[q][i].z * v[q][i].z + v[q][i].w * v[q][i].w;
        }
      } else {
#pragma unroll
        for (int i = 0; i < 4; ++i) v[q][i] = (f32x4v){0.f, 0.f, 0.f, 0.f};
      }
    }
#pragma unroll
    for (int q = 0; q < 4; ++q) {
      if (!act[q]) continue;
      const int m = m0 + q;
      const float* shift = modp[q] + (which ? 3 : 0) * DM;
      const float* scale = modp[q] + (which ? 4 : 1) * DM;
      const float tot = wave_sum(ss[q]);
      const float rstd = rsqrtf(tot * (1.f / DM) + 1e-6f);
#pragma unroll
      for (int i = 0; i < 4; ++i) {
        const int k = i * 256 + lane * 4;
        const f32x4v gg = *(const f32x4v*)(g + k), sc = *(const f32x4v*)(scale + k), sh = *(const f32x4v*)(shift + k);
        const float o0 = (v[q][i].x * rstd * gg.x) * (1.f + sc.x) + sh.x;
        const float o1 = (v[q][i].y * rstd * gg.y) * (1.f + sc.y) + sh.y;
        const float o2 = (v[q][i].z * rstd * gg.z) * (1.f + sc.z) + sh.z;
        const float o3 = (v[q][i].w * rstd * gg.w) * (1.f + sc.w) + sh.w;
        uint2 pk; pk.x = pack2(o0, o1); pk.y = pack2(o2, o3);
        *(uint2*)(H + (size_t)m * DM + k) = pk;
      }
    }
  }
}

namespace pg8 {
#define PG8_LAS __attribute__((address_space(3)))
typedef unsigned short bf16_t;
typedef short bf16x8 __attribute__((ext_vector_type(8)));
typedef float f32x4 __attribute__((ext_vector_type(4)));
typedef unsigned u32x4 __attribute__((ext_vector_type(4)));
constexpr int BM = 256, BK = 64, HALF = 128, HTB = HALF * BK * 2  , STAGE_BYTES = 8 * HTB, NXCD = 8, WGM = 8;

__host__ __device__ __forceinline__ int lds_byte(int r, int c) { const int st = (r >> 4) * 2 + (c >> 5), rr = r & 15, cc = c & 31, ob = rr * 64 + cc * 2; return st * 1024 + (ob ^ (((ob >> 9) & 1) << 5)); }
__host__ __device__ __forceinline__ void stage_rc(int b, int& R, int& C) { const int st = b / 1024, sb = b % 1024, swz = sb ^ (((sb >> 9) & 1) << 5); R = (st >> 1) * 16 + swz / 64; C = (st & 1) * 32 + (swz % 64) / 2; }
__host__ __device__ __forceinline__ int perm32(int rho) { const int n = rho >> 4, i = rho & 15; return 8 * (i >> 2) + 4 * n + (i & 3); }

struct Unit { int pm, pn; int kofs = 0; };
struct Gemm { const bf16_t* A; const bf16_t* Bt; int M, N, K; int ntov = 0; };

__device__ __forceinline__ unsigned cvt_pk_bf16(float lo, float hi) { unsigned r; asm volatile("v_cvt_pk_bf16_f32 %0, %1, %2" : "=v"(r) : "v"(lo), "v"(hi)); return r; }
template <class Epi, class Sched, bool ALIGN_EPI = false, bool SP2 = false>
__device__ __forceinline__ void gemm_phase(PG8_LAS unsigned char* lds, const Gemm g, const Sched& S, const Epi& E) {
    int tid_ = threadIdx.x; asm volatile("" : "+v"(tid_));
    const int tid = tid_, wid = __builtin_amdgcn_readfirstlane(tid >> 6), lane = tid & 63, wr = wid >> 2, wc = wid & 3, fr = lane & 15, fq = lane >> 4;
    const int K = g.K, nt = g.ntov ? g.ntov : K / BK;
    unsigned voffA[2], voffB[2];
#pragma unroll
    for (int i = 0; i < 2; ++i) { int R, C; stage_rc(tid * 16 + i * 8192, R, C); const int Rb = Epi::PERM ? ((R & ~31) + perm32(R & 31)) : R;
        voffA[i] = (unsigned)(R * K + C) * 2u; voffB[i] = (unsigned)(Rb * K + C) * 2u; }
    const size_t kstep = (size_t)(BK * 2);
    const size_t hstep = (size_t)HALF * K * 2;
    const size_t tstep = 2 * hstep;
    const unsigned ldsw = (unsigned)wid * 1024u;
    const int aoff = lds_byte(wr * 64 + fr, fq * 8), boff = lds_byte(wc * 32 + fr, fq * 8);
#define PG8_SA(b, h) (((b) * 2 + (h)) * HTB)
#define PG8_SB(b, h) ((4 + (b) * 2 + (h)) * HTB)
#define PG8_STAGE(bufoff, gbase, voff) do { _Pragma("unroll") for (int _i = 0; _i < 2; ++_i) \
        __builtin_amdgcn_global_load_lds((const unsigned*)((const char*)(gbase) + (voff)[_i]), (PG8_LAS unsigned*)(lds + (bufoff) + ldsw + _i * 8192), 16, 0, 0); } while (0)
#define PG8_LDA(dst, b, h) do { _Pragma("unroll") for (int m = 0; m < 4; ++m) _Pragma("unroll") for (int k = 0; k < 2; ++k) dst[m][k] = *(const PG8_LAS bf16x8*)(lds + PG8_SA(b, h) + aoff + m * 2048 + k * 1024); } while (0)
#define PG8_LDB(dst, b, h) do { _Pragma("unroll") for (int n = 0; n < 2; ++n) _Pragma("unroll") for (int k = 0; k < 2; ++k) dst[n][k] = *(const PG8_LAS bf16x8*)(lds + PG8_SB(b, h) + boff + n * 2048 + k * 1024); } while (0)
#define PG8_MMA(ai, bj, At, Bt) do { __builtin_amdgcn_s_setprio(1); _Pragma("unroll") for (int m = 0; m < 4; ++m) _Pragma("unroll") for (int n = 0; n < 2; ++n) _Pragma("unroll") for (int k = 0; k < 2; ++k) \
        acc[ai][bj][m][n] = __builtin_amdgcn_mfma_f32_16x16x32_bf16(Bt[n][k], At[m][k], acc[ai][bj][m][n], 0, 0, 0); __builtin_amdgcn_s_setprio(0); } while (0)
#define PG8_WAIT_V(n) asm volatile("s_waitcnt vmcnt(" #n ")" ::: "memory")
#define PG8_WAIT_L(n) asm volatile("s_waitcnt lgkmcnt(" #n ")" ::: "memory")
#define PG8_BAR __builtin_amdgcn_s_barrier()
#define PG8_SCHED __builtin_amdgcn_sched_barrier(0)
    Unit cur, nxt; int ui = 0;
    if (!S.next(0, cur)) return;
    f32x4 acc[2][2][4][2];
#pragma unroll
    for (int a = 0; a < 2; ++a)
#pragma unroll
        for (int b = 0; b < 2; ++b)
#pragma unroll
            for (int m = 0; m < 4; ++m)
#pragma unroll
                for (int n = 0; n < 2; ++n) acc[a][b][m][n] = (f32x4){0.f, 0.f, 0.f, 0.f};
    bf16x8 At[4][2], B0[2][2], B1[2][2];
    const char* cA = (const char*)g.A + (size_t)cur.pm * tstep + 2 * cur.kofs; const char* cB = (const char*)g.Bt + (size_t)cur.pn * tstep + 2 * cur.kofs;
    S.a_ready(cur);
    if constexpr (SP2) {
        PG8_STAGE(PG8_SB(0, 0), cB, voffB); PG8_STAGE(PG8_SB(0, 1), cB + hstep, voffB); PG8_STAGE(PG8_SA(0, 0), cA, voffA); PG8_STAGE(PG8_SA(0, 1), cA + hstep, voffA);
        if (wr == 1) PG8_BAR;
        PG8_WAIT_V(2); PG8_BAR;
        PG8_STAGE(PG8_SB(1, 0), cB + kstep, voffB); PG8_STAGE(PG8_SA(1, 0), cA + kstep, voffA); PG8_STAGE(PG8_SB(1, 1), cB + hstep + kstep, voffB);
        PG8_WAIT_V(6); PG8_BAR;
    } else {
        PG8_STAGE(PG8_SB(0, 0), cB, voffB); PG8_STAGE(PG8_SA(0, 0), cA, voffA); PG8_STAGE(PG8_SB(0, 1), cB + hstep, voffB); PG8_STAGE(PG8_SA(0, 1), cA + hstep, voffA);
        if (wr == 1) PG8_BAR;
        PG8_WAIT_V(4); PG8_BAR;
        PG8_STAGE(PG8_SB(1, 0), cB + kstep, voffB); PG8_STAGE(PG8_SA(1, 0), cA + kstep, voffA); PG8_STAGE(PG8_SB(1, 1), cB + hstep + kstep, voffB);
        PG8_WAIT_V(6); PG8_BAR;
    }
    for (;;) {
        const bool has_next = S.next(ui + 1, nxt);
        const char* nA = has_next ? (const char*)g.A + (size_t)nxt.pm * tstep + 2 * nxt.kofs : cA; const char* nB = has_next ? (const char*)g.Bt + (size_t)nxt.pn * tstep + 2 * nxt.kofs : cB;
        for (int t = 0; t < nt; t += 2) {
            const bool last = (t == nt - 2);
            const char* a1 = cA + (size_t)(t + 1) * kstep;
            const char* a2 = last ? nA : cA + (size_t)(t + 2) * kstep; const char* b2 = last ? nB : cB + (size_t)(t + 2) * kstep;
            const char* a3 = a2 + kstep; const char* b3 = b2 + kstep;
            if (last && has_next) S.a_ready(nxt);
            if constexpr (SP2) {
            PG8_LDB(B0, 0, 0); PG8_LDB(B1, 0, 1); PG8_SCHED; PG8_LDA(At, 0, 0); PG8_STAGE(PG8_SA(1, 1), a1 + hstep, voffA);
            PG8_WAIT_V(8); PG8_WAIT_L(0); PG8_BAR; PG8_MMA(0, 0, At, B0); PG8_MMA(0, 1, At, B1); PG8_BAR; PG8_SCHED;
            PG8_LDA(At, 0, 1); PG8_STAGE(PG8_SB(0, 0), b2, voffB); PG8_STAGE(PG8_SB(0, 1), b2 + hstep, voffB); PG8_STAGE(PG8_SA(0, 0), a2, voffA);
            PG8_WAIT_V(8); PG8_WAIT_L(0); PG8_BAR; PG8_MMA(1, 0, At, B0); PG8_MMA(1, 1, At, B1); PG8_BAR; PG8_SCHED;
            PG8_LDB(B0, 1, 0); PG8_LDB(B1, 1, 1); PG8_SCHED; PG8_LDA(At, 1, 0); PG8_STAGE(PG8_SA(0, 1), a2 + hstep, voffA);
            PG8_WAIT_V(8); PG8_WAIT_L(0); PG8_BAR; PG8_MMA(0, 0, At, B0); PG8_MMA(0, 1, At, B1); PG8_BAR; PG8_SCHED;
            PG8_LDA(At, 1, 1); PG8_STAGE(PG8_SB(1, 0), b3, voffB); PG8_STAGE(PG8_SB(1, 1), b3 + hstep, voffB); PG8_STAGE(PG8_SA(1, 0), a3, voffA);
            PG8_WAIT_V(8); PG8_WAIT_L(0); PG8_BAR; PG8_MMA(1, 0, At, B0); PG8_MMA(1, 1, At, B1); PG8_BAR; PG8_SCHED;
            } else {
            PG8_LDB(B0, 0, 0); PG8_SCHED; PG8_LDA(At, 0, 0); PG8_STAGE(PG8_SA(1, 1), a1 + hstep, voffA);
            PG8_WAIT_L(8); PG8_BAR; PG8_WAIT_L(0); PG8_MMA(0, 0, At, B0); PG8_BAR; PG8_SCHED;
            PG8_LDB(B1, 0, 1); PG8_STAGE(PG8_SB(0, 0), b2, voffB);
            PG8_BAR; PG8_WAIT_L(0); PG8_MMA(0, 1, At, B1); PG8_BAR;
            PG8_LDA(At, 0, 1); PG8_STAGE(PG8_SA(0, 0), a2, voffA);
            PG8_BAR; PG8_WAIT_L(0); PG8_MMA(1, 0, At, B0); PG8_BAR; PG8_SCHED;
            PG8_STAGE(PG8_SB(0, 1), b2 + hstep, voffB);
            PG8_WAIT_V(6); PG8_BAR; PG8_MMA(1, 1, At, B1); PG8_BAR;
            PG8_LDB(B0, 1, 0); PG8_SCHED; PG8_LDA(At, 1, 0); PG8_STAGE(PG8_SA(0, 1), a2 + hstep, voffA);
            PG8_WAIT_L(8); PG8_BAR; PG8_WAIT_L(0); PG8_MMA(0, 0, At, B0); PG8_BAR; PG8_SCHED;
            PG8_LDB(B1, 1, 1); PG8_STAGE(PG8_SB(1, 0), b3, voffB);
            PG8_BAR; PG8_WAIT_L(0); PG8_MMA(0, 1, At, B1); PG8_BAR;
            PG8_LDA(At, 1, 1); PG8_STAGE(PG8_SA(1, 0), a3, voffA);
            PG8_BAR; PG8_WAIT_L(0); PG8_MMA(1, 0, At, B0); PG8_BAR; PG8_SCHED;
            PG8_STAGE(PG8_SB(1, 1), b3 + hstep, voffB);
            PG8_WAIT_V(6); PG8_BAR; PG8_MMA(1, 1, At, B1); PG8_BAR;
            }
        }
        if constexpr (ALIGN_EPI) { if (wr == 0) PG8_BAR; }
        if constexpr (!Epi::AFTER_DRAIN) { E(acc, cur, wr, wc, fr, fq); S.done(cur); }
        if (!has_next) break;
#pragma unroll
        for (int a = 0; a < 2; ++a)
#pragma unroll
            for (int b = 0; b < 2; ++b)
#pragma unroll
                for (int m = 0; m < 4; ++m)
#pragma unroll
                    for (int n = 0; n < 2; ++n) acc[a][b][m][n] = (f32x4){0.f, 0.f, 0.f, 0.f};
        cur = nxt; cA = nA; cB = nB; ++ui;
        if constexpr (ALIGN_EPI) { if (wr == 1) PG8_BAR; }
    }
    PG8_WAIT_V(0);
    if constexpr (!ALIGN_EPI) { if (wr == 0) PG8_BAR; }
    PG8_BAR;
    if constexpr (Epi::AFTER_DRAIN) { E.fused(acc, cur, wr, wc, fr, fq, lds, wid, lane); S.done(cur); }
#undef PG8_SA
#undef PG8_SB
#undef PG8_STAGE
#undef PG8_LDA
#undef PG8_LDB
#undef PG8_MMA
#undef PG8_WAIT_V
#undef PG8_WAIT_L
#undef PG8_BAR
#undef PG8_SCHED
}
}

struct MySched {
  int nM, nN, nwg, G, c; bool skip; bool lora = false;
  DI void init(int nM_, int nN_, int G_, int c_, bool skip_) { nM = nM_; nN = nN_; nwg = nM_ * nN_; G = G_; c = c_; skip = skip_; }
  DI bool next(int i, pg8::Unit& u) const {
    const long L = (long)i * G + c; if (L >= nwg) return false;
    int wgid = (int)L; { const int q = nwg / pg8::NXCD, r = nwg % pg8::NXCD, xcd = wgid % pg8::NXCD, off = wgid / pg8::NXCD; wgid = (xcd < r ? xcd * (q + 1) : r * (q + 1) + (xcd - r) * q) + off; }
    const int nig = pg8::WGM * nN, gid = wgid / nig, fm = gid * pg8::WGM, gsz = (nM - fm) < pg8::WGM ? (nM - fm) : pg8::WGM;
    const int pm = fm + ((wgid % nig) % gsz); u.pn = (wgid % nig) / gsz;
    u.pm = skip ? (pm >> 3) * 9 + (pm & 7) : pm;
    u.kofs = lora ? ((u.pn < 4) ? (u.pn >> 1) * 128 : 256) : 0;
    return true;
  }
  DI void a_ready(const pg8::Unit&) const {}
  DI void done(const pg8::Unit&) const {}
};

struct EpiP {
  static constexpr bool PERM = true, AFTER_DRAIN = false;
  bfr* P;
  DI void operator()(const pg8::f32x4 (&acc)[2][2][4][2], const pg8::Unit& u, int wr, int wc, int fr, int fq) const {
    const int row0 = u.pm * 256 + wr * 64 + fr, col0 = u.pn * 256 + wc * 32 + 8 * fq;
#pragma unroll
    for (int ai = 0; ai < 2; ++ai)
#pragma unroll
      for (int m = 0; m < 4; ++m) {
        bfr* rowp = P + (size_t)(row0 + ai * 128 + m * 16) * PW;
#pragma unroll
        for (int bj = 0; bj < 2; ++bj) {
          const int col = col0 + bj * 128;
          if (col < PW) {
            pg8::f32x4 v0 = acc[ai][bj][m][0], v1 = acc[ai][bj][m][1];
            u32x4 w; w.x = pg8::cvt_pk_bf16(v0[0], v0[1]); w.y = pg8::cvt_pk_bf16(v0[2], v0[3]); w.z = pg8::cvt_pk_bf16(v1[0], v1[1]); w.w = pg8::cvt_pk_bf16(v1[2], v1[3]);
            *(u32x4*)(rowp + col) = w;
          }
        }
      }
  }
};

struct EpiResid {
  static constexpr bool PERM = true, AFTER_DRAIN = false;
  const float* xin; const float* cin; float* xout; float* xc; const float* modl; int gi; bool src_input;
  DI void operator()(const pg8::f32x4 (&acc)[2][2][4][2], const pg8::Unit& u, int wr, int wc, int fr, int fq) const {
    const int row0 = u.pm * 256 + wr * 64 + fr, col0 = u.pn * 256 + wc * 32 + 8 * fq;
    const int b = (u.pm * 256) / TT;
#pragma unroll
    for (int ai = 0; ai < 2; ++ai)
#pragma unroll
      for (int m = 0; m < 4; ++m) {
        const int row = row0 + ai * 128 + m * 16;
        const int t = row - b * TT;
        const bool isc = t >= TL;
        float* dst = isc ? xc + ((size_t)b * TC + (t - TL)) * DM : xout + ((size_t)b * TL + t) * DM;
        const float* src = src_input ? (isc ? cin + ((size_t)b * TC + (t - TL)) * DM : xin + ((size_t)b * TL + t) * DM) : dst;
        const float* gate = modl + (size_t)(isc ? 16 : b) * 6144 + gi * DM;
#pragma unroll
        for (int bj = 0; bj < 2; ++bj) {
          const int col = col0 + bj * 128;
#pragma unroll
          for (int n = 0; n < 2; ++n) {
            pg8::f32x4 sv = *(const pg8::f32x4*)(src + col + 4 * n);
            pg8::f32x4 gv = *(const pg8::f32x4*)(gate + col + 4 * n);
            pg8::f32x4 o = sv + gv * acc[ai][bj][m][n];
            *(pg8::f32x4*)(dst + col + 4 * n) = o;
          }
        }
      }
  }
};

struct EpiFfn {
  static constexpr bool PERM = true, AFTER_DRAIN = false;
  bfr* A2; float* EDGE; const float* cw; const float* cb; LAS float* bd;
  DI void operator()(const pg8::f32x4 (&acc)[2][2][4][2], const pg8::Unit& u, int wr, int wc, int fr, int fq) const {
    const int jl = wc * 32 + 8 * fq;
    const int j0 = u.pn * 128 + jl;
    const int m0 = u.pm * 256;
    const int t0 = m0 % TT;
#pragma unroll
    for (int ai = 0; ai < 2; ++ai) {
      const int sl = ai * 2 + wr;
      if (fr == 0) { *(LAS pg8::f32x4*)(bd + (sl * 2 + 0) * 128 + jl) = acc[ai][1][0][0]; *(LAS pg8::f32x4*)(bd + (sl * 2 + 0) * 128 + jl + 4) = acc[ai][1][0][1]; }
      if (fr == 15) { *(LAS pg8::f32x4*)(bd + (sl * 2 + 1) * 128 + jl) = acc[ai][1][3][0]; *(LAS pg8::f32x4*)(bd + (sl * 2 + 1) * 128 + jl + 4) = acc[ai][1][3][1]; }
    }
    asm volatile("s_waitcnt lgkmcnt(0)" ::: "memory");
    __builtin_amdgcn_s_barrier();
    asm volatile("" ::: "memory");
    const int srcl = __builtin_amdgcn_mov_dpp(fr, 0x121, 0xf, 0xf, true);
    const bool ror1_is_prev = (srcl == ((fr + 15) & 15));
    unsigned keep[2][4][2];
#pragma unroll
    for (int n = 0; n < 2; ++n) {
      const pg8::f32x4 c0 = *(const pg8::f32x4*)(cw + j0 + 4 * n), c1 = *(const pg8::f32x4*)(cw + DFF + j0 + 4 * n), c2 = *(const pg8::f32x4*)(cw + 2 * DFF + j0 + 4 * n), cbv = *(const pg8::f32x4*)(cb + j0 + 4 * n);
#pragma unroll
      for (int ai = 0; ai < 2; ++ai) {
        const int sl = ai * 2 + wr;
        const pg8::f32x4 bprev = (sl > 0) ? *(const LAS pg8::f32x4*)(bd + ((sl - 1) * 2 + 1) * 128 + jl + 4 * n) : (pg8::f32x4){0.f, 0.f, 0.f, 0.f};
        const pg8::f32x4 bnext = (sl < 3) ? *(const LAS pg8::f32x4*)(bd + ((sl + 1) * 2 + 0) * 128 + jl + 4 * n) : (pg8::f32x4){0.f, 0.f, 0.f, 0.f};
#pragma unroll
        for (int m = 0; m < 4; ++m) {
          const int rl = ai * 128 + wr * 64 + m * 16 + fr;
          const int t = t0 + rl;
          const bool first = (t == 0) || (t == TL);
          const bool last = (t == TL - 1) || (t == TT - 1);
          const bool etop = (rl == 0) && !first, ebot = (rl == 255) && !last;
          float ov[4];
#pragma unroll
          for (int e = 0; e < 4; ++e) {
            const float g = acc[ai][1][m][n][e], uv = acc[ai][0][m][n][e];
            const float xa = dppf<0x121>(g), xb = dppf<0x12F>(g);
            const float same_prev = ror1_is_prev ? xa : xb, same_next = ror1_is_prev ? xb : xa;
            float oprev, onext;
            if (m > 0) { const float pv = acc[ai][1][m > 0 ? m - 1 : 0][n][e]; const float pa = dppf<0x121>(pv), pb = dppf<0x12F>(pv); oprev = ror1_is_prev ? pa : pb; }
            else oprev = bprev[e];
            if (m < 3) { const float nv = acc[ai][1][m < 3 ? m + 1 : 3][n][e]; const float na = dppf<0x121>(nv), nb = dppf<0x12F>(nv); onext = ror1_is_prev ? nb : na; }
            else onext = bnext[e];
            const float gm = (fr == 0) ? oprev : same_prev;
            const float gp = (fr == 15) ? onext : same_next;
            if (etop) {
              float* ed = EDGE + ((size_t)(u.pm * 2 + 0) * DFF + j0 + 4 * n + e) * 3;
              ed[0] = c1[e] * g + c2[e] * gp + cbv[e]; ed[1] = uv; ed[2] = g;
            } else if (ebot) {
              float* ed = EDGE + ((size_t)(u.pm * 2 + 1) * DFF + j0 + 4 * n + e) * 3;
              ed[0] = c0[e] * gm + c1[e] * g + cbv[e]; ed[1] = uv; ed[2] = g;
            }
            const float z = c0[e] * gm + c1[e] * g + c2[e] * gp + cbv[e];
            ov[e] = z * __builtin_amdgcn_rcpf(1.f + __expf(-z)) * uv;
          }
          {
            const unsigned p0 = pg8::cvt_pk_bf16(ov[0], ov[1]), p1 = pg8::cvt_pk_bf16(ov[2], ov[3]);
            if (n == 0) { keep[ai][m][0] = p0; keep[ai][m][1] = p1; }
            else if (!etop && !ebot) {
              u32x4 w; w.x = keep[ai][m][0]; w.y = keep[ai][m][1]; w.z = p0; w.w = p1;
              *(u32x4*)(A2 + (size_t)(m0 + rl) * DFF + j0) = w;
            }
          }
        }
      }
    }
  }
};

struct EpiLora {
  static constexpr bool PERM = true, AFTER_DRAIN = false;
  bfr* RW; const float* w0; const float* a0;
  DI void operator()(const pg8::f32x4 (&acc)[2][2][4][2], const pg8::Unit& u, int wr, int wc, int fr, int fq) const {
    const int row0 = u.pm * 256 + wr * 64 + fr, cl = wc * 32 + 8 * fq;
    const int kind = u.pn;
    bfr* base = RW + (size_t)kind * MR * 256;
    const float osc = (kind < 2) ? 0.6065306597126334f : 1.f;
#pragma unroll
    for (int bj = 0; bj < 2; ++bj) {
      const int c0 = cl + bj * 128;
      float bias[8];
#pragma unroll
      for (int q = 0; q < 8; ++q) bias[q] = (kind < 2) ? w0[kind * 256 + c0 + q] : ((kind < 4) ? a0[(kind - 2) * 256 + c0 + q] : 0.f);
#pragma unroll
      for (int ai = 0; ai < 2; ++ai)
#pragma unroll
        for (int m = 0; m < 4; ++m) {
          float o[8];
#pragma unroll
          for (int n = 0; n < 2; ++n)
#pragma unroll
            for (int e = 0; e < 4; ++e) {
              const float x = acc[ai][bj][m][n][e] + bias[n * 4 + e];
              const float sg = osc * __builtin_amdgcn_rcpf(1.f + __expf(-x));
              o[n * 4 + e] = (kind < 4) ? sg : x;
            }
          u32x4 w; w.x = pg8::cvt_pk_bf16(o[0], o[1]); w.y = pg8::cvt_pk_bf16(o[2], o[3]); w.z = pg8::cvt_pk_bf16(o[4], o[5]); w.w = pg8::cvt_pk_bf16(o[6], o[7]);
          *(u32x4*)(base + (size_t)(row0 + ai * 128 + m * 16) * 256 + c0) = w;
        }
    }
  }
};

DN void phase_lora(const Params& p, int l) {
  pg8::Gemm g; g.A = (const bfr*)(p.ws + OFF_HO); g.Bt = (const bfr*)(p.ws + OFF_WLORA); g.M = MR; g.N = 1280; { int kk_ = 384; asm volatile("" : "+s"(kk_)); g.K = kk_; }
  MySched S; S.init(144, 5, gridDim.x, blockIdx.x, false); S.lora = true;
  { int nt_ = 2; asm volatile("" : "+s"(nt_)); g.ntov = nt_; }
  EpiLora E; E.RW = (bfr*)(p.ws + OFF_RWIN); E.w0 = p.in[oidx(11)] + (size_t)l * 512; E.a0 = p.in[oidx(13)] + (size_t)l * 512;
  pg8::gemm_phase<EpiLora, MySched, true, true>((LAS unsigned char*)dynlds, g, S, E);
}

DN void phase_g1(const Params& p) {
  pg8::Gemm g; g.A = (const bfr*)(p.ws + OFF_HO); g.Bt = (const bfr*)(p.ws + OFF_WIN); g.M = MR; g.N = NINP; g.K = DM;
  MySched S; S.init(144, 13, gridDim.x, blockIdx.x, false);
  EpiP E; E.P = (bfr*)(p.ws + OFF_P);
  pg8::gemm_phase<EpiP, MySched, true, true>((LAS unsigned char*)dynlds, g, S, E);
}

DN void phase_resid_gemm(const Params& p, int l, const bfr* A, const bfr* Bt, int K, int gi, bool src_input, bool skip_ctx) {
  pg8::Gemm g; g.A = A; g.Bt = Bt; g.M = MR; g.N = DM; g.K = K;
  MySched S; S.init(skip_ctx ? 128 : 144, 4, gridDim.x, blockIdx.x, skip_ctx);
  EpiResid E; E.xin = p.in[oidx(0)]; E.cin = p.in[oidx(2)]; E.xout = p.out; E.xc = (float*)(p.ws + OFF_XC);
  E.modl = (const float*)(p.ws + OFF_MOD) + (size_t)l * 17 * 6144; E.gi = gi; E.src_input = src_input;
  pg8::gemm_phase<EpiResid, MySched, true, true>((LAS unsigned char*)dynlds, g, S, E);
}

DN void phase_g3(const Params& p, int l, bool skip_ctx) {
  pg8::Gemm g; g.A = (const bfr*)(p.ws + OFF_HO); g.Bt = (const bfr*)(p.ws + OFF_WUP); g.M = MR; g.N = 2 * DFF; g.K = DM;
  MySched S; S.init(skip_ctx ? 128 : 144, 22, gridDim.x, blockIdx.x, skip_ctx);
  EpiFfn E; E.A2 = (bfr*)(p.ws + OFF_A2); E.EDGE = (float*)(p.ws + OFF_EDGE);
  E.cw = p.in[oidx(29)] + (size_t)l * 3 * DFF; E.cb = p.in[oidx(30)] + (size_t)l * DFF; E.bd = (LAS float*)(dynlds + LDS_BD_OFF);
  pg8::gemm_phase<EpiFfn, MySched, true, true>((LAS unsigned char*)dynlds, g, S, E);
}

DN void phase_fix(const Params& p, int l, bool skip_ctx) {
  bfr* A2 = (bfr*)(p.ws + OFF_A2);
  const float* EDGE = (const float*)(p.ws + OFF_EDGE);
  const float* cw = p.in[oidx(29)] + (size_t)l * 3 * DFF;
  const int gtid = VB() * 256 + otid(), gsz = NVB() * 256;
  const int total = 144 * 2 * DFF;
  for (int i = gtid; i < total; i += gsz) {
    int j = i % DFF, te = i / DFF;
    int tile = te >> 1, e = te & 1;
    int m0 = tile * 256;
    int t0 = m0 % TT;
    if (skip_ctx && t0 >= TL) continue;
    int rl = e ? 255 : 0;
    int t = t0 + rl;
    bool first = (t == 0) || (t == TL);
    bool last = (t == TL - 1) || (t == TT - 1);
    if (e == 0 && first) continue;
    if (e == 1 && last) continue;
    const float* me = EDGE + ((size_t)(tile * 2 + e) * DFF + j) * 3;
    const float* ot = e ? (EDGE + ((size_t)((tile + 1) * 2 + 0) * DFF + j) * 3) : (EDGE + ((size_t)((tile - 1) * 2 + 1) * DFF + j) * 3);
    float cwr = e ? cw[2 * DFF + j] : cw[j];
    float z = me[0] + cwr * ot[2];
    float a = z * __builtin_amdgcn_rcpf(1.f + __expf(-z)) * me[1];
    A2[(size_t)(m0 + rl) * DFF + j] = f2bf(a);
  }
}

DN void fix_own_tiles(const Params& p, int l, bool skip_ctx) {
  bfr* A2 = (bfr*)(p.ws + OFF_A2);
  const float* EDGE = (const float*)(p.ws + OFF_EDGE);
  const float* cw = p.in[oidx(29)] + (size_t)l * 3 * DFF;
  MySched S; S.init(skip_ctx ? 128 : 144, 4, gridDim.x, blockIdx.x, skip_ctx);
  int tid_ = threadIdx.x; asm volatile("" : "+v"(tid_));
  pg8::Unit u;
  for (int ui = 0; S.next(ui, u); ++ui) {
    const int tile = u.pm, m0 = tile * 256, t0 = m0 % TT;
    for (int i = tid_; i < 2 * DFF; i += 512) {
      const int e = (i >= DFF) ? 1 : 0, j = i - e * DFF;
      const int rl = e ? 255 : 0, t = t0 + rl;
      const bool first = (t == 0) || (t == TL), last = (t == TL - 1) || (t == TT - 1);
      if ((e == 0 && first) || (e == 1 && last)) continue;
      const float* me = EDGE + ((size_t)(tile * 2 + e) * DFF + j) * 3;
      const float* ot = e ? (EDGE + ((size_t)((tile + 1) * 2 + 0) * DFF + j) * 3) : (EDGE + ((size_t)((tile - 1) * 2 + 1) * DFF + j) * 3);
      const float cwr = e ? cw[2 * DFF + j] : cw[j];
      const float z = me[0] + cwr * ot[2];
      const float a = z * __builtin_amdgcn_rcpf(1.f + __expf(-z)) * me[1];
      A2[(size_t)(m0 + rl) * DFF + j] = f2bf(a);
    }
  }
  __syncthreads();
}

DI void unpack8(const u32x4 w, float (&o)[8]) {
  o[0] = __uint_as_float(w.x << 16); o[1] = __uint_as_float(w.x & 0xffff0000u);
  o[2] = __uint_as_float(w.y << 16); o[3] = __uint_as_float(w.y & 0xffff0000u);
  o[4] = __uint_as_float(w.z << 16); o[5] = __uint_as_float(w.z & 0xffff0000u);
  o[6] = __uint_as_float(w.w << 16); o[7] = __uint_as_float(w.w & 0xffff0000u);
}
DI void load8f(const float* p8, float (&o)[8]) {
  const f32x4v a = *(const f32x4v*)p8, b = *(const f32x4v*)(p8 + 4);
  o[0] = a.x; o[1] = a.y; o[2] = a.z; o[3] = a.w; o[4] = b.x; o[5] = b.y; o[6] = b.z; o[7] = b.w;
}
DI void shifted_load(const bfr* P, int m, int t, int col, const float* mu, float& out) {
  const bfr* row = P + (size_t)m * PW + col;
  float x = bf2f(row[0]);
  float xp = (t != 0 && t != TL) ? bf2f(row[-PW]) : 0.f;
  float xn = (t != TL - 1 && t != TT - 1) ? bf2f(row[PW]) : 0.f;
  out = x + mu[col] * (xp - x) + mu[1152 + col] * (xn - x);
}

DN void phase_prep(const Params& p, int l, char* smem) {
  bfr* P = (bfr*)(p.ws + OFF_P);
  bfr* AL = (bfr*)(p.ws + OFF_HO);
  const float* rope = (const float*)(p.ws + OFF_ROPE);
  const float* mu = p.in[oidx(10)] + (size_t)l * 2 * 1152;
  const int tid = otid(), lane = tid & 63, w = tid >> 6;
  for (int tile = VB(); tile < MR / 8; tile += NVB()) {
    int m0 = tile * 8;
    for (int i = tid; i < 8 * 48; i += 256) {
      const int tk = i / 48, g8 = i - tk * 48, cc = g8 * 8;
      const int m = m0 + tk, t = m % TT;
      const bfr* row = P + (size_t)m * PW + 768 + cc;
      const bool hp = (t != 0 && t != TL), hn = (t != TL - 1 && t != TT - 1);
      const u32x4 cur = *(const u32x4*)row;
      u32x4 prv = {0u, 0u, 0u, 0u}, nxt = {0u, 0u, 0u, 0u};
      if (hp) prv = *(const u32x4*)(row - PW);
      if (hn) nxt = *(const u32x4*)(row + PW);
      const f32x4v ma0 = *(const f32x4v*)(mu + 768 + cc), ma1 = *(const f32x4v*)(mu + 768 + cc + 4);
      const f32x4v mb0 = *(const f32x4v*)(mu + 1152 + 768 + cc), mb1 = *(const f32x4v*)(mu + 1152 + 768 + cc + 4);
      const float m0v[8] = {ma0.x, ma0.y, ma0.z, ma0.w, ma1.x, ma1.y, ma1.z, ma1.w};
      const float m1v[8] = {mb0.x, mb0.y, mb0.z, mb0.w, mb1.x, mb1.y, mb1.z, mb1.w};
      const unsigned cw_[4] = {cur.x, cur.y, cur.z, cur.w}, pw_[4] = {prv.x, prv.y, prv.z, prv.w}, nw_[4] = {nxt.x, nxt.y, nxt.z, nxt.w};
      float val[8];
#pragma unroll
      for (int e = 0; e < 8; ++e) {
        const float x = (e & 1) ? __uint_as_float(cw_[e >> 1] & 0xffff0000u) : __uint_as_float(cw_[e >> 1] << 16);
        const float xp = (e & 1) ? __uint_as_float(pw_[e >> 1] & 0xffff0000u) : __uint_as_float(pw_[e >> 1] << 16);
        const float xn = (e & 1) ? __uint_as_float(nw_[e >> 1] & 0xffff0000u) : __uint_as_float(nw_[e >> 1] << 16);
        const float xs = x + m0v[e] * (xp - x) + m1v[e] * (xn - x);
        val[e] = (cc < 128) ? (1.f - 2.f * __builtin_amdgcn_rcpf(1.f + __expf(2.f * xs))) : ((cc < 256) ? xs : __builtin_amdgcn_rcpf(1.f + __expf(-xs)));
      }
      u32x4 ow; ow.x = pack2(val[0], val[1]); ow.y = pack2(val[2], val[3]); ow.z = pack2(val[4], val[5]); ow.w = pack2(val[6], val[7]);
      *(u32x4*)(AL + (size_t)m * 384 + cc) = ow;
    }
    for (int i = tid; i < 8 * 112; i += 256) {
      const int tk = i / 112, gi = i - tk * 112;
      const int m = m0 + tk, t = m % TT;
      const bool da = gi < 64;
      const int gq = gi - 64;
      const bool isq = da ? (gi < 32) : (gq < 32);
      const int col = da ? (1152 + 8 * gi) : (isq ? (2720 + 8 * gq) : (2976 + 8 * (gq - 32)));
      const int dofs = da ? ((gi & 3) * 8) : ((gq & 7) * 8);
      bfr* ptr = P + (size_t)m * PW + col;
      float x[8], gs[8];
      unpack8(*(const u32x4*)ptr, x);
      load8f(da ? (p.in[oidx(21)] + (l * 2 + (isq ? 0 : 1)) * 32 + dofs) : (p.in[oidx(27)] + (l * 2 + (isq ? 0 : 1)) * 64 + dofs), gs);
      float ss = 0.f;
#pragma unroll
      for (int e = 0; e < 8; ++e) ss += x[e] * x[e];
      ss += dppf<0xB1>(ss); ss += dppf<0x4E>(ss);
      const float ss8 = ss + dppf<0x141>(ss);
      const float rstd = da ? rsqrtf(ss * (1.f / 32.f) + 1e-6f) : rsqrtf(ss8 * (1.f / 64.f) + 1e-6f);
      float y[8];
#pragma unroll
      for (int e = 0; e < 8; ++e) y[e] = x[e] * rstd * gs[e];
      float yp2[8], yp4[8];
#pragma unroll
      for (int e = 0; e < 8; ++e) { yp2[e] = __shfl_xor(y[e], 2); yp4[e] = __shfl_xor(y[e], 4); }
      if (t < TL) {
        const int idx0 = da ? ((gi & 1) * 8) : ((gq & 3) * 8);
        const bool first = da ? ((gi & 2) == 0) : ((gq & 4) == 0);
        float cs[8], sn[8];
        load8f(rope + t * 96 + (da ? 0 : 32) + idx0, cs);
        load8f(rope + t * 96 + (da ? 16 : 64) + idx0, sn);
#pragma unroll
        for (int e = 0; e < 8; ++e) {
          const float yp = da ? yp2[e] : yp4[e];
          y[e] = first ? (y[e] * cs[e] - yp * sn[e]) : (y[e] * cs[e] + yp * sn[e]);
        }
      }
      const float qs = isq ? (da ? 0.25503486f : 0.18033688f) : 1.f;
      u32x4 ow; ow.x = pack2(y[0] * qs, y[1] * qs); ow.y = pack2(y[2] * qs, y[3] * qs); ow.z = pack2(y[4] * qs, y[5] * qs); ow.w = pack2(y[6] * qs, y[7] * qs);
      *(u32x4*)ptr = ow;
    }
  }
}

template <int D>
DI void attn_pass(const bfr* __restrict__ P, int b, int tq_wave, int qcol, int kcol, int vcol, int key0, int nkt, char* smem, f32x16 (&o)[2]) {
  constexpr int KS = D / 16, KP = D + 8, NKR = D / 32, CPR = D / 8;
  bfr* sbase = (bfr*)dynlds;
  const int tid = otid(), lane = tid & 63, r = lane & 31, h = lane >> 5;
  const int gt = vhalf() * 256 + tid;
  bf16x8 qf[KS];
  {
    const bfr* qrow = P + (size_t)(b * TT + tq_wave + r) * PW + qcol;
#pragma unroll
    for (int ks = 0; ks < KS; ++ks) qf[ks] = *(const bf16x8*)(qrow + ks * 16 + h * 8);
  }
  f32x16 accO[2];
#pragma unroll
  for (int i = 0; i < 16; ++i) { accO[0][i] = 0.f; accO[1][i] = 0.f; }
  float mrun = -1e30f, lsum = 0.f;
  u32x4 kreg[1], vreg[1];
  const bfr* Pb = P + (size_t)(b * TT + key0) * PW;
  static_assert(D == 64, "block-mode attention pass stages one 16-byte K chunk per thread");
  { int c = gt, row = c >> 3, kc = c & 7; kreg[0] = *(const u32x4*)(Pb + (size_t)row * PW + kcol + kc * 8); vreg[0] = *(const u32x4*)(Pb + (size_t)row * PW + vcol + kc * 8); }
  for (int kt = 0; kt < nkt; ++kt) {
    bfr* sK = sbase + (kt & 1) * 9216;
    bfr* sV = sK + 64 * 72;
    { int c = gt, row = c >> 3, kc = c & 7; *(u32x4*)(sK + row * KP + kc * 8) = kreg[0]; }
    for (int i = 0; i < 1; ++i) {
      int c = gt, row = c >> 3, kc = c & 7;
      unsigned wds[4] = {vreg[i].x, vreg[i].y, vreg[i].z, vreg[i].w};
#pragma unroll
      for (int e = 0; e < 4; ++e) {
        sV[(kc * 8 + 2 * e) * 72 + (row ^ (kc << 3))] = (bfr)(wds[e] & 0xffffu);
        sV[(kc * 8 + 2 * e + 1) * 72 + (row ^ (kc << 3))] = (bfr)(wds[e] >> 16);
      }
    }
    __syncthreads();
    if (kt + 1 < nkt) {
      const bfr* Pn = Pb + (size_t)(kt + 1) * 64 * PW;
      { int c = gt, row = c >> 3, kc = c & 7; kreg[0] = *(const u32x4*)(Pn + (size_t)row * PW + kcol + kc * 8); vreg[0] = *(const u32x4*)(Pn + (size_t)row * PW + vcol + kc * 8); }
    }
    f32x16 s[2];
#pragma unroll
    for (int t2 = 0; t2 < 2; ++t2) {
#pragma unroll
      for (int i = 0; i < 16; ++i) s[t2][i] = 0.f;
#pragma unroll
      for (int ks = 0; ks < KS; ++ks) {
        bf16x8 a = *(const bf16x8*)(sK + (t2 * 32 + r) * KP + ks * 16 + h * 8);
        s[t2] = MFMA32(a, qf[ks], s[t2]);
      }
    }
    float mx = s[0][0];
#pragma unroll
    for (int i = 0; i < 16; ++i) { mx = fmaxf(mx, s[0][i]); mx = fmaxf(mx, s[1][i]); }
    mx = fmaxf(mx, __shfl_xor(mx, 32));
    float mnew = fmaxf(mrun, mx);
    float alpha = __builtin_amdgcn_exp2f(mrun - mnew);
    mrun = mnew;
    float ps = 0.f;
#pragma unroll
    for (int i = 0; i < 16; ++i) {
      s[0][i] = __builtin_amdgcn_exp2f(s[0][i] - mnew); ps += s[0][i];
      s[1][i] = __builtin_amdgcn_exp2f(s[1][i] - mnew); ps += s[1][i];
    }
    lsum = lsum * alpha + ps;
#pragma unroll
    for (int i = 0; i < 16; ++i) { accO[0][i] *= alpha; accO[1][i] *= alpha; }
#pragma unroll
    for (int t2 = 0; t2 < 2; ++t2)
#pragma unroll
      for (int j = 0; j < 2; ++j) {
        unsigned pk[4];
#pragma unroll
        for (int e = 0; e < 4; ++e) pk[e] = pack2(s[t2][8 * j + 2 * e], s[t2][8 * j + 2 * e + 1]);
        u32x4 pku = {pk[0], pk[1], pk[2], pk[3]};
        bf16x8 pf = __builtin_bit_cast(bf16x8, pku);
#pragma unroll
        for (int dt = 0; dt < 2; ++dt) {
          const int vsw = (((dt * 32 + r) >> 3) & 7) << 3;
          const bfr* vrow = sV + (dt * 32 + r) * 72;
          s16x4 lo = *(const s16x4*)(vrow + ((t2 * 32 + 16 * j + 4 * h) ^ vsw));
          s16x4 hi = *(const s16x4*)(vrow + ((t2 * 32 + 16 * j + 4 * h + 8) ^ vsw));
          bf16x8 vf = __builtin_shufflevector(lo, hi, 0, 1, 2, 3, 4, 5, 6, 7);
          accO[dt] = MFMA32(vf, pf, accO[dt]);
        }
      }
  }
  lsum += __shfl_xor(lsum, 32);
  float inv = 1.f / lsum;
#pragma unroll
  for (int i = 0; i < 16; ++i) { o[0][i] = accO[0][i] * inv; o[1][i] = accO[1][i] * inv; }
}

DI void attn_pass_da(const bfr* __restrict__ P, int b, int tq_wave, int qcol, int kcol, int vcol, int key0, int nkt, char* smem, f32x16 (&o0)[2], f32x16 (&o1)[2]) {
  constexpr int KP = 72;
  bfr* sbase = (bfr*)dynlds;
  const int tid = otid(), lane = tid & 63, r = lane & 31, h = lane >> 5;
  const int gt = vhalf() * 256 + tid;
  bf16x8 qf[4];
  {
    const bfr* qrow = P + (size_t)(b * TT + tq_wave + r) * PW + qcol;
#pragma unroll
    for (int ks = 0; ks < 4; ++ks) qf[ks] = *(const bf16x8*)(qrow + ks * 16 + h * 8);
  }
  f32x16 acc0[2], acc1[2];
#pragma unroll
  for (int i = 0; i < 16; ++i) { acc0[0][i] = 0.f; acc0[1][i] = 0.f; acc1[0][i] = 0.f; acc1[1][i] = 0.f; }
  float m0 = -1e30f, l0 = 0.f, m1 = -1e30f, l1 = 0.f;
  u32x4 kreg[1], vreg[1];
  const bfr* Pb = P + (size_t)(b * TT + key0) * PW;
  { int c = gt, row = c >> 3, kc = c & 7; kreg[0] = *(const u32x4*)(Pb + (size_t)row * PW + kcol + kc * 8); vreg[0] = *(const u32x4*)(Pb + (size_t)row * PW + vcol + kc * 8); }
  for (int kt = 0; kt < nkt; ++kt) {
    bfr* sK = sbase + (kt & 1) * 9216;
    bfr* sV = sK + 64 * 72;
    { int c = gt, row = c >> 3, kc = c & 7; *(u32x4*)(sK + row * KP + kc * 8) = kreg[0]; }
    for (int i = 0; i < 1; ++i) {
      int c = gt, row = c >> 3, kc = c & 7;
      unsigned wds[4] = {vreg[i].x, vreg[i].y, vreg[i].z, vreg[i].w};
#pragma unroll
      for (int e = 0; e < 4; ++e) {
        sV[(kc * 8 + 2 * e) * 72 + (row ^ (kc << 3))] = (bfr)(wds[e] & 0xffffu);
        sV[(kc * 8 + 2 * e + 1) * 72 + (row ^ (kc << 3))] = (bfr)(wds[e] >> 16);
      }
    }
    __syncthreads();
    if (kt + 1 < nkt) {
      const bfr* Pn = Pb + (size_t)(kt + 1) * 64 * PW;
      { int c = gt, row = c >> 3, kc = c & 7; kreg[0] = *(const u32x4*)(Pn + (size_t)row * PW + kcol + kc * 8); vreg[0] = *(const u32x4*)(Pn + (size_t)row * PW + vcol + kc * 8); }
    }
    f32x16 s0[2], s1[2];
#pragma unroll
    for (int t2 = 0; t2 < 2; ++t2) {
#pragma unroll
      for (int i = 0; i < 16; ++i) { s0[t2][i] = 0.f; s1[t2][i] = 0.f; }
#pragma unroll
      for (int ks = 0; ks < 2; ++ks) {
        bf16x8 a0 = *(const bf16x8*)(sK + (t2 * 32 + r) * KP + ks * 16 + h * 8);
        bf16x8 a1 = *(const bf16x8*)(sK + (t2 * 32 + r) * KP + 32 + ks * 16 + h * 8);
        s0[t2] = MFMA32(a0, qf[ks], s0[t2]);
        s1[t2] = MFMA32(a1, qf[2 + ks], s1[t2]);
      }
    }
    float mx0 = s0[0][0], mx1 = s1[0][0];
#pragma unroll
    for (int i = 0; i < 16; ++i) { mx0 = fmaxf(mx0, fmaxf(s0[0][i], s0[1][i])); mx1 = fmaxf(mx1, fmaxf(s1[0][i], s1[1][i])); }
    mx0 = fmaxf(mx0, __shfl_xor(mx0, 32)); mx1 = fmaxf(mx1, __shfl_xor(mx1, 32));
    const float mn0 = fmaxf(m0, mx0), mn1 = fmaxf(m1, mx1);
    const float al0 = __builtin_amdgcn_exp2f(m0 - mn0), al1 = __builtin_amdgcn_exp2f(m1 - mn1);
    m0 = mn0; m1 = mn1;
    float ps0 = 0.f, ps1 = 0.f;
#pragma unroll
    for (int i = 0; i < 16; ++i) {
      s0[0][i] = __builtin_amdgcn_exp2f(s0[0][i] - mn0); ps0 += s0[0][i];
      s0[1][i] = __builtin_amdgcn_exp2f(s0[1][i] - mn0); ps0 += s0[1][i];
      s1[0][i] = __builtin_amdgcn_exp2f(s1[0][i] - mn1); ps1 += s1[0][i];
      s1[1][i] = __builtin_amdgcn_exp2f(s1[1][i] - mn1); ps1 += s1[1][i];
    }
    l0 = l0 * al0 + ps0; l1 = l1 * al1 + ps1;
#pragma unroll
    for (int i = 0; i < 16; ++i) { acc0[0][i] *= al0; acc0[1][i] *= al0; acc1[0][i] *= al1; acc1[1][i] *= al1; }
#pragma unroll
    for (int t2 = 0; t2 < 2; ++t2)
#pragma unroll
      for (int j = 0; j < 2; ++j) {
        u32x4 pk0, pk1;
        pk0.x = pack2(s0[t2][8 * j + 0], s0[t2][8 * j + 1]); pk0.y = pack2(s0[t2][8 * j + 2], s0[t2][8 * j + 3]);
        pk0.z = pack2(s0[t2][8 * j + 4], s0[t2][8 * j + 5]); pk0.w = pack2(s0[t2][8 * j + 6], s0[t2][8 * j + 7]);
        pk1.x = pack2(s1[t2][8 * j + 0], s1[t2][8 * j + 1]); pk1.y = pack2(s1[t2][8 * j + 2], s1[t2][8 * j + 3]);
        pk1.z = pack2(s1[t2][8 * j + 4], s1[t2][8 * j + 5]); pk1.w = pack2(s1[t2][8 * j + 6], s1[t2][8 * j + 7]);
        const bf16x8 pf0 = __builtin_bit_cast(bf16x8, pk0), pf1 = __builtin_bit_cast(bf16x8, pk1);
#pragma unroll
        for (int dt = 0; dt < 2; ++dt) {
          const int vsw = (((dt * 32 + r) >> 3) & 7) << 3;
          const bfr* vrow = sV + (dt * 32 + r) * 72;
          s16x4 lo = *(const s16x4*)(vrow + ((t2 * 32 + 16 * j + 4 * h) ^ vsw));
          s16x4 hi = *(const s16x4*)(vrow + ((t2 * 32 + 16 * j + 4 * h + 8) ^ vsw));
          bf16x8 vf = __builtin_shufflevector(lo, hi, 0, 1, 2, 3, 4, 5, 6, 7);
          acc0[dt] = MFMA32(vf, pf0, acc0[dt]);
          acc1[dt] = MFMA32(vf, pf1, acc1[dt]);
        }
      }
  }
  l0 += __shfl_xor(l0, 32); l1 += __shfl_xor(l1, 32);
  const float i0 = 1.f / l0, i1 = 1.f / l1;
#pragma unroll
  for (int i = 0; i < 16; ++i) { o0[0][i] = acc0[0][i] * i0; o0[1][i] = acc0[1][i] * i0; o1[0][i] = acc1[0][i] * i1; o1[1][i] = acc1[1][i] * i1; }
}

DI void store_o(bfr* O, int m, int colbase, int h, const f32x16 (&o)[2]) {
#pragma unroll
  for (int dt = 0; dt < 2; ++dt)
#pragma unroll
    for (int g4 = 0; g4 < 4; ++g4) {
      int dv = dt * 32 + 8 * g4 + 4 * h;
      uint2 pk; pk.x = pack2(o[dt][4 * g4], o[dt][4 * g4 + 1]); pk.y = pack2(o[dt][4 * g4 + 2], o[dt][4 * g4 + 3]);
      *(uint2*)(O + (size_t)m * DM + colbase + dv) = pk;
    }
}

DN void da_item(const Params& p, int l, int b, int hd, int tq0, int key0, int nkt, char* smem) {
  const bfr* P = (const bfr*)(p.ws + OFF_P);
  bfr* O = (bfr*)(p.ws + OFF_HO);
  const int tid = otid(), lane = tid & 63, w = tid >> 6, r = lane & 31, h = lane >> 5;
  const float* lv = p.in[oidx(22)] + l * 128;
  float d01 = (lane < 32) ? lv[lane] * lv[32 + lane] : 0.f;
  float d23 = (lane < 32) ? lv[64 + lane] * lv[96 + lane] : 0.f;
  d01 = wave_sum(d01); d23 = wave_sum(d23);
  float lam_init = 0.8f - 0.6f * expf(-0.3f * (float)l);
  float lam = expf(d01) - expf(d23) + lam_init;
  f32x16 o0[2], o1[2];
  int tqw = tq0 + vhalf() * 128 + w * 32;
  attn_pass_da(P, b, tqw, 1152 + hd * 64, 1408 + hd * 64, 1664 + hd * 64, key0, nkt, smem, o0, o1);
  float ss = 0.f;
#pragma unroll
  for (int dt = 0; dt < 2; ++dt)
#pragma unroll
    for (int i = 0; i < 16; ++i) { float v = o0[dt][i] - lam * o1[dt][i]; o0[dt][i] = v; ss += v * v; }
  ss += __shfl_xor(ss, 32);
  float rstd = rsqrtf(ss * (1.f / 64.f) + 1e-6f) * (1.f - lam_init);
  const float* sg = p.in[oidx(23)] + l * 64;
#pragma unroll
  for (int dt = 0; dt < 2; ++dt)
#pragma unroll
    for (int i = 0; i < 16; ++i) { int dv = dt * 32 + 8 * (i >> 2) + 4 * h + (i & 3); o0[dt][i] = o0[dt][i] * rstd * sg[dv]; }
  store_o(O, b * TT + tqw + r, 256 + hd * 64, h, o0);
}

DN void gqa_item(const Params& p, int b, int hq, int tq0, int key0, int nkt, char* smem) {
  const bfr* P = (const bfr*)(p.ws + OFF_P);
  bfr* O = (bfr*)(p.ws + OFF_HO);
  const int tid = otid(), lane = tid & 63, w = tid >> 6, r = lane & 31, h = lane >> 5;
  f32x16 o[2];
  int tqw = tq0 + vhalf() * 128 + w * 32;
  attn_pass<64>(P, b, tqw, 2720 + hq * 64, 2976 + (hq >> 1) * 64, 3104 + (hq >> 1) * 64, key0, nkt, smem, o);
  store_o(O, b * TT + tqw + r, 768 + hq * 64, h, o);
}

struct RwRegs { bfr lr[4][3], lk[4][3], lv[4][3], le[4], la[4]; };

DN void rw_scan_item(const Params& p, int l, int item, bool need_ctx, int mode) {
  const int dir = item & 1, hh = (item >> 1) & 3, b = item >> 3;
  const int half = vhalf();
  float* lbase = (float*)dynlds;
  const bfr* P = (const bfr*)(p.ws + OFF_P);
  const bfr* RWE = (const bfr*)(p.ws + OFF_RWIN) + (size_t)dir * MR * 256;
  const bfr* RWA = (const bfr*)(p.ws + OFF_RWIN) + (size_t)(2 + dir) * MR * 256;
  bfr* Y = (bfr*)(p.ws + OFF_RWY) + (size_t)dir * MR * 256;
  const int tid = otid();
  const int nchunks = TT / 16;
  auto tokof = [&](int tau) -> int {
    if (dir == 0) return (tau < TC) ? (TL + tau) : (tau - TC);
    return (tau < TC) ? (TL + TC - 1 - tau) : (TL - 1 - (tau - TC));
  };
  __syncthreads();
  if (half == 1) {
    const int ch = tid & 63, c256 = hh * 64 + ch;
    const float* mu = p.in[oidx(10)] + (size_t)l * 2 * 1152;
    const float mr0 = mu[c256], mr1 = mu[1152 + c256], mk0 = mu[256 + c256], mk1 = mu[1152 + 256 + c256], mv0 = mu[512 + c256], mv1 = mu[1152 + 512 + c256];
    const float kkw = p.in[oidx(16)][l * 256 + c256], kaw = p.in[oidx(17)][l * 256 + c256];
    auto gload = [&](RwRegs& R, int c) {
#pragma unroll
      for (int i = 0; i < 4; ++i) {
        int s = (tid >> 6) + 4 * i;
        int t = tokof(c * 16 + s);
        size_t m = (size_t)b * TT + t;
        bool hp = (t != 0 && t != TL), hn = (t != TL - 1 && t != TT - 1);
        const bfr* row = P + m * PW + c256;
        R.lr[i][1] = row[0]; R.lk[i][1] = row[256]; R.lv[i][1] = row[512];
        R.lr[i][0] = hp ? row[-PW] : (bfr)0; R.lk[i][0] = hp ? row[256 - PW] : (bfr)0; R.lv[i][0] = hp ? row[512 - PW] : (bfr)0;
        R.lr[i][2] = hn ? row[PW] : (bfr)0; R.lk[i][2] = hn ? row[256 + PW] : (bfr)0; R.lv[i][2] = hn ? row[512 + PW] : (bfr)0;
        R.le[i] = RWE[m * 256 + c256]; R.la[i] = RWA[m * 256 + c256];
      }
    };
    auto prep = [&](const RwRegs& R, int c) {
      float* vec = lbase + (c & 1) * 7168;
      float* vvv = vec + 16 * 5 * 64;
#pragma unroll
      for (int i = 0; i < 4; ++i) {
        int s = (tid >> 6) + 4 * i;
        float r0 = bf2f(R.lr[i][1]), k0 = bf2f(R.lk[i][1]), v0 = bf2f(R.lv[i][1]);
        float rr = r0 + mr0 * (bf2f(R.lr[i][0]) - r0) + mr1 * (bf2f(R.lr[i][2]) - r0);
        float kx = k0 + mk0 * (bf2f(R.lk[i][0]) - k0) + mk1 * (bf2f(R.lk[i][2]) - k0);
        float vx = v0 + mv0 * (bf2f(R.lv[i][0]) - v0) + mv1 * (bf2f(R.lv[i][2]) - v0);
        float kkp = kx * kkw;
        float ss = wave_sum(kkp * kkp);
        float kk = kkp * rsqrtf(ss + 1e-12f);
        float a = bf2f(R.la[i]);
        float wdec = __expf(-bf2f(R.le[i]));
        float kd = kx * (1.f + (a - 1.f) * kaw);
        float* vs = vec + s * 320;
        vs[ch] = wdec; vs[64 + ch] = kd; vs[128 + ch] = -kk; vs[192 + ch] = kk * a; vs[256 + ch] = rr;
        vvv[s * 64 + ch] = vx;
      }
    };
    auto yout = [&](int cprev) {
      const float* yb = lbase + (cprev & 1) * 7168 + 16 * 5 * 64 + 16 * 64;
#pragma unroll
      for (int i = 0; i < 4; ++i) {
        int idx = tid + 256 * i;
        int s = idx >> 6, rr = idx & 63;
        int t = tokof(cprev * 16 + s);
        if (t < TL || need_ctx) Y[((size_t)b * TT + t) * 256 + hh * 64 + rr] = f2bf(yb[s * 64 + rr]);
      }
    };
    RwRegs RA, RB;
    gload(RA, 0);
    gload(RB, 1);
    prep(RA, 0);
    if (mode != 2) gload(RA, 2);
    __syncthreads();
#pragma unroll 1
    for (int c = 0; c < nchunks; c += 2) {
      prep(RB, c + 1);
      if (c + 3 < nchunks && mode != 2) gload(RB, c + 3);
      if (c > 0 && mode == 0) yout(c - 1);
      __syncthreads();
      if (c + 2 < nchunks) prep(RA, c + 2);
      if (c + 4 < nchunks && mode != 2) gload(RA, c + 4);
      if (mode == 0) yout(c);
      __syncthreads();
    }
    if (mode == 0) yout(nchunks - 1);
  } else {
    const int rq = tid >> 4, j16 = tid & 15;
    f32x2 S[4][2];
#pragma unroll
    for (int k = 0; k < 4; ++k) { S[k][0] = (f32x2){0.f, 0.f}; S[k][1] = (f32x2){0.f, 0.f}; }
    __syncthreads();
#pragma unroll 1
    for (int c = 0; c < nchunks; ++c) {
      const float* vec = lbase + (c & 1) * 7168;
      const float* vvv = vec + 16 * 5 * 64;
      float* ybuf = lbase + (c & 1) * 7168 + 16 * 5 * 64 + 16 * 64;
      if (mode != 1) {
        float ykeep[4] = {0.f, 0.f, 0.f, 0.f};
#pragma unroll
        for (int hb = 0; hb < 2; ++hb) {
          float yp[4][8];
#pragma unroll
          for (int s8 = 0; s8 < 8; ++s8) {
            const int s = hb * 8 + s8;
            const float* vs = vec + s * 320 + j16 * 4;
            const f32x4v w0 = *(const f32x4v*)(vs);
            const f32x4v d0 = *(const f32x4v*)(vs + 64);
            const f32x4v a0 = *(const f32x4v*)(vs + 128);
            const f32x4v b0 = *(const f32x4v*)(vs + 192);
            const f32x4v q0 = *(const f32x4v*)(vs + 256);
            float sa[4], vi[4];
#pragma unroll
            for (int k = 0; k < 4; ++k) {
              vi[k] = vvv[s * 64 + rq + 16 * k];
              f32x2 t = S[k][0] * a0.xy;
              t = S[k][1] * a0.zw + t;
              sa[k] = t.x + t.y;
            }
#pragma unroll
            for (int k = 0; k < 4; ++k) sa[k] += dppf<0xB1>(sa[k]);
#pragma unroll
            for (int k = 0; k < 4; ++k) sa[k] += dppf<0x4E>(sa[k]);
#pragma unroll
            for (int k = 0; k < 4; ++k) sa[k] += dppf<0x141>(sa[k]);
#pragma unroll
            for (int k = 0; k < 4; ++k) sa[k] += dppf<0x140>(sa[k]);
#pragma unroll
            for (int k = 0; k < 4; ++k) {
              const f32x2 s2 = (f32x2){sa[k], sa[k]}, v2 = (f32x2){vi[k], vi[k]};
              S[k][0] = S[k][0] * w0.xy + (s2 * b0.xy + v2 * d0.xy);
              S[k][1] = S[k][1] * w0.zw + (s2 * b0.zw + v2 * d0.zw);
              f32x2 y2 = S[k][0] * q0.xy;
              y2 = S[k][1] * q0.zw + y2;
              yp[k][s8] = y2.x + y2.y;
            }
          }
#pragma unroll
          for (int s8 = 0; s8 < 8; ++s8)
#pragma unroll
            for (int k = 0; k < 4; ++k) {
              float ra = yp[k][s8];
              ra += dppf<0xB1>(ra); ra += dppf<0x4E>(ra); ra += dppf<0x141>(ra); ra += dppf<0x140>(ra);
              ykeep[k] = ((hb * 8 + s8) == j16) ? ra : ykeep[k];
            }
        }
#pragma unroll
        for (int k = 0; k < 4; ++k) ybuf[j16 * 64 + rq + 16 * k] = ykeep[k];
      }
      __syncthreads();
    }
  }
  __syncthreads();
}

DI float logsigf_(float x) { return fminf(x, 0.f) - __logf(1.f + __expf(-fabsf(x))); }

DN void gla_state_item(const Params& p, int l, int item, char* smem) {
  const int dir = item & 1, hh = (item >> 1) & 3, b = item >> 3;
  float* kk_ = (float*)smem;
  float* vv = kk_ + 64 * 33;
  float* bb = vv + 64 * 64;
  float* gg = bb + 64 * 33;
  float* sbend = gg + 64 * 16;
  float* segs = sbend + 32;
  const bfr* P = (const bfr*)(p.ws + OFF_P);
  float* GS = (float*)(p.ws + OFF_GS);
  const int tid = otid();
  const int d = tid >> 3, e0 = (tid & 7) * 8;
  float S[8];
#pragma unroll
  for (int e = 0; e < 8; ++e) S[e] = 0.f;
  const int dl = tid & 31, lgrp = tid >> 5;
  float a2c[16];
#pragma unroll
  for (int q = 0; q < 16; ++q) a2c[q] = p.in[oidx(24)][((size_t)(l * 2 + dir) * 16 + q) * 128 + hh * 32 + dl];
  const float abv = p.in[oidx(25)][(l * 2 + dir) * 128 + hh * 32 + dl];
  for (int c = 0; c < 36; ++c) {
    int cs = (dir == 0) ? (c < 4 ? 32 + c : c - 4) : (c < 4 ? 35 - c : 35 - c);
    size_t m0 = (size_t)b * TT + cs * 64;
    vsync_l();
    {
      float t8[8];
      { const int li = tid >> 2, d8 = (tid & 3) * 8; unpack8(*(const u32x4*)(P + (m0 + li) * PW + 2048 + hh * 32 + d8), t8);
#pragma unroll
        for (int e = 0; e < 8; ++e) kk_[li * 33 + d8 + e] = t8[e]; }
#pragma unroll
      for (int i = 0; i < 2; ++i) { const int c = tid + 256 * i, li = c >> 3, e8 = (c & 7) * 8; unpack8(*(const u32x4*)(P + (m0 + li) * PW + 2176 + hh * 64 + e8), t8);
        *(f32x4v*)(vv + li * 64 + e8) = (f32x4v){t8[0], t8[1], t8[2], t8[3]}; *(f32x4v*)(vv + li * 64 + e8 + 4) = (f32x4v){t8[4], t8[5], t8[6], t8[7]}; }
      if (tid < 128) { const int li = tid >> 1, q8 = (tid & 1) * 8; unpack8(*(const u32x4*)(P + (m0 + li) * PW + 2432 + dir * 16 + q8), t8);
        *(f32x4v*)(gg + li * 16 + q8) = (f32x4v){t8[0], t8[1], t8[2], t8[3]}; *(f32x4v*)(gg + li * 16 + q8 + 4) = (f32x4v){t8[4], t8[5], t8[6], t8[7]}; }
    }
    vsync_l();
    {
      float lgv[8];
#pragma unroll
      for (int li = 0; li < 8; ++li) {
        int lt = lgrp * 8 + li;
        float x = abv;
#pragma unroll
        for (int q = 0; q < 16; ++q) x += gg[lt * 16 + q] * a2c[q];
        lgv[li] = logsigf_(x) * (1.f / 16.f);
      }
      if (dir == 0) {
#pragma unroll
        for (int li = 1; li < 8; ++li) lgv[li] += lgv[li - 1];
        segs[lgrp * 32 + dl] = lgv[7];
      } else {
#pragma unroll
        for (int li = 6; li >= 0; --li) lgv[li] += lgv[li + 1];
        segs[lgrp * 32 + dl] = lgv[0];
      }
      vsync_l();
      float off = 0.f, tot = 0.f;
#pragma unroll
      for (int sg = 0; sg < 8; ++sg) {
        const float sv = segs[sg * 32 + dl];
        tot += sv;
        if ((dir == 0) ? (sg < lgrp) : (sg > lgrp)) off += sv;
      }
#pragma unroll
      for (int li = 0; li < 8; ++li) bb[(lgrp * 8 + li) * 33 + dl] = lgv[li] + off;
      if (lgrp == 0) sbend[dl] = tot;
    }
    vsync_l();
    for (int i = tid; i < 2048; i += 256) { int li = i >> 5, dd = i & 31; kk_[li * 33 + dd] *= __expf(sbend[dd] - bb[li * 33 + dd]); }
    {
      float* dst = GS + ((((size_t)b * 36 + cs) * 4 + hh) * 2 + dir) * 2048 + d * 64 + e0;
      *(float4*)dst = make_float4(S[0], S[1], S[2], S[3]);
      *(float4*)(dst + 4) = make_float4(S[4], S[5], S[6], S[7]);
    }
    vsync_l();
    float dec = __expf(sbend[d]);
#pragma unroll
    for (int e = 0; e < 8; ++e) S[e] *= dec;
    for (int lt = 0; lt < 64; ++lt) {
      float kv = kk_[lt * 33 + d];
      float4 v0 = *(const float4*)(vv + lt * 64 + e0), v1 = *(const float4*)(vv + lt * 64 + e0 + 4);
      S[0] += kv * v0.x; S[1] += kv * v0.y; S[2] += kv * v0.z; S[3] += kv * v0.w;
      S[4] += kv * v1.x; S[5] += kv * v1.y; S[6] += kv * v1.z; S[7] += kv * v1.w;
    }
  }
}

DN void gla_finish_item(const Params& p, int l, int b, int cs, int hh, char* smem) {
  bfr* QiB = (bfr*)smem;
  bfr* KiB = QiB + 64 * 40;
  bfr* StB = KiB + 64 * 40;
  bfr* VtB = StB + 64 * 40;
  float* bb = (float*)(VtB + 64 * 72);
  float* gg = bb + 64 * 33;
  float* segs = gg + 64 * 16;
  float* ssq = segs + 256;
  const bfr* P = (const bfr*)(p.ws + OFF_P);
  const float* GS = (const float*)(p.ws + OFF_GS);
  bfr* O = (bfr*)(p.ws + OFF_HO);
  const int tid = otid(), lane = tid & 63, w = tid >> 6, r = lane & 31, h = lane >> 5;
  const int et = w >> 1, it = w & 1;
  const size_t m0 = (size_t)b * TT + cs * 64;
  const int dl = tid & 31, lgrp = tid >> 5;
  const int li4 = tid >> 2, d8 = (tid & 3) * 8;
  f32x16 accO;
#pragma unroll
  for (int i = 0; i < 16; ++i) accO[i] = 0.f;
  vsync();
  {
#pragma unroll
    for (int i = 0; i < 2; ++i) {
      const int c = tid + 256 * i, row = c >> 3, kc = c & 7;
      const u32x4 v = *(const u32x4*)(P + (m0 + row) * PW + 2176 + hh * 64 + kc * 8);
      const unsigned wds[4] = {v.x, v.y, v.z, v.w};
#pragma unroll
      for (int e = 0; e < 4; ++e) {
        VtB[(kc * 8 + 2 * e) * 72 + (row ^ (kc << 3))] = (bfr)(wds[e] & 0xffffu);
        VtB[(kc * 8 + 2 * e + 1) * 72 + (row ^ (kc << 3))] = (bfr)(wds[e] >> 16);
      }
    }
  }
#pragma unroll 1
  for (int dir = 0; dir < 2; ++dir) {
    vsync_l();
    float q8[8], k8[8];
    unpack8(*(const u32x4*)(P + (m0 + li4) * PW + 1920 + hh * 32 + d8), q8);
    unpack8(*(const u32x4*)(P + (m0 + li4) * PW + 2048 + hh * 32 + d8), k8);
    if (tid < 128) {
      float t8[8];
      const int lg_ = tid >> 1, qq = (tid & 1) * 8;
      unpack8(*(const u32x4*)(P + (m0 + lg_) * PW + 2432 + dir * 16 + qq), t8);
      *(f32x4v*)(gg + lg_ * 16 + qq) = (f32x4v){t8[0], t8[1], t8[2], t8[3]}; *(f32x4v*)(gg + lg_ * 16 + qq + 4) = (f32x4v){t8[4], t8[5], t8[6], t8[7]};
    }
    {
      const float* Sg = GS + ((((size_t)b * 36 + cs) * 4 + hh) * 2 + dir) * 2048;
      const int d = tid >> 3, e8 = (tid & 7) * 8;
      float s8[8];
      load8f(Sg + d * 64 + e8, s8);
#pragma unroll
      for (int e = 0; e < 8; ++e) StB[(e8 + e) * 40 + d] = f2bf(s8[e]);
    }
    vsync_l();
    {
      float a2c[16];
#pragma unroll
      for (int q = 0; q < 16; ++q) a2c[q] = p.in[oidx(24)][((size_t)(l * 2 + dir) * 16 + q) * 128 + hh * 32 + dl];
      const float abv = p.in[oidx(25)][(l * 2 + dir) * 128 + hh * 32 + dl];
      float lgv[8];
#pragma unroll
      for (int li = 0; li < 8; ++li) {
        int lt = lgrp * 8 + li;
        float x = abv;
#pragma unroll
        for (int q = 0; q < 16; ++q) x += gg[lt * 16 + q] * a2c[q];
        lgv[li] = logsigf_(x) * (1.f / 16.f);
      }
      if (dir == 0) {
#pragma unroll
        for (int li = 1; li < 8; ++li) lgv[li] += lgv[li - 1];
        segs[lgrp * 32 + dl] = lgv[7];
      } else {
#pragma unroll
        for (int li = 6; li >= 0; --li) lgv[li] += lgv[li + 1];
        segs[lgrp * 32 + dl] = lgv[0];
      }
      vsync_l();
      float off = 0.f;
#pragma unroll
      for (int sg = 0; sg < 8; ++sg) {
        const float sv = segs[sg * 32 + dl];
        if ((dir == 0) ? (sg < lgrp) : (sg > lgrp)) off += sv;
      }
#pragma unroll
      for (int li = 0; li < 8; ++li) bb[(lgrp * 8 + li) * 33 + dl] = lgv[li] + off;
    }
    vsync_l();
    {
      float qo[8], ko[8];
#pragma unroll
      for (int e = 0; e < 8; ++e) {
        const float bv = bb[li4 * 33 + d8 + e];
        qo[e] = q8[e] * 0.17677669529663687f * __expf(bv);
        ko[e] = k8[e] * __expf(-bv);
      }
      u32x4 qw, kw;
      qw.x = pack2(qo[0], qo[1]); qw.y = pack2(qo[2], qo[3]); qw.z = pack2(qo[4], qo[5]); qw.w = pack2(qo[6], qo[7]);
      kw.x = pack2(ko[0], ko[1]); kw.y = pack2(ko[2], ko[3]); kw.z = pack2(ko[4], ko[5]); kw.w = pack2(ko[6], ko[7]);
      *(u32x4*)(QiB + li4 * 40 + d8) = qw;
      *(u32x4*)(KiB + li4 * 40 + d8) = kw;
    }
    vsync_l();
    {
      bf16x8 qf[2];
#pragma unroll
      for (int ks = 0; ks < 2; ++ks) qf[ks] = *(const bf16x8*)(QiB + (it * 32 + r) * 40 + ks * 16 + h * 8);
      f32x16 sT[2];
#pragma unroll
      for (int jt = 0; jt < 2; ++jt) {
#pragma unroll
        for (int i = 0; i < 16; ++i) sT[jt][i] = 0.f;
#pragma unroll
        for (int ks = 0; ks < 2; ++ks) {
          const bf16x8 a = *(const bf16x8*)(KiB + (jt * 32 + r) * 40 + ks * 16 + h * 8);
          sT[jt] = MFMA32(a, qf[ks], sT[jt]);
        }
        const int ti = it * 32 + r;
#pragma unroll
        for (int i = 0; i < 16; ++i) {
          const int tj = jt * 32 + 8 * (i >> 2) + 4 * h + (i & 3);
          const bool keep = (dir == 0) ? (tj <= ti) : (tj >= ti);
          sT[jt][i] = keep ? sT[jt][i] : 0.f;
        }
      }
#pragma unroll
      for (int jt = 0; jt < 2; ++jt)
#pragma unroll
        for (int jj = 0; jj < 2; ++jj) {
          u32x4 pk;
          pk.x = pack2(sT[jt][8 * jj + 0], sT[jt][8 * jj + 1]); pk.y = pack2(sT[jt][8 * jj + 2], sT[jt][8 * jj + 3]);
          pk.z = pack2(sT[jt][8 * jj + 4], sT[jt][8 * jj + 5]); pk.w = pack2(sT[jt][8 * jj + 6], sT[jt][8 * jj + 7]);
          const bf16x8 pf = __builtin_bit_cast(bf16x8, pk);
          const int vsw = (((et * 32 + r) >> 3) & 7) << 3;
          const bfr* vrow = VtB + (et * 32 + r) * 72;
          s16x4 lo = *(const s16x4*)(vrow + ((jt * 32 + 16 * jj + 4 * h) ^ vsw));
          s16x4 hi = *(const s16x4*)(vrow + ((jt * 32 + 16 * jj + 4 * h + 8) ^ vsw));
          bf16x8 vf = __builtin_shufflevector(lo, hi, 0, 1, 2, 3, 4, 5, 6, 7);
          accO = MFMA32(vf, pf, accO);
        }
#pragma unroll
      for (int ks = 0; ks < 2; ++ks) {
        const bf16x8 a = *(const bf16x8*)(StB + (et * 32 + r) * 40 + ks * 16 + h * 8);
        accO = MFMA32(a, qf[ks], accO);
      }
    }
  }
  {
    float ss = 0.f;
#pragma unroll
    for (int i = 0; i < 16; ++i) ss += accO[i] * accO[i];
    ss += __shfl_xor(ss, 32);
    if (h == 0) ssq[w * 32 + r] = ss;
    vsync_l();
    const float tot = ssq[w * 32 + r] + ssq[(w ^ 2) * 32 + r];
    const float rstd = rsqrtf(tot * (1.f / 64.f) + 1e-6f);
    const size_t m = m0 + it * 32 + r;
    const float* ng = p.in[oidx(26)] + l * 64;
#pragma unroll
    for (int g4 = 0; g4 < 4; ++g4) {
      const int e0 = et * 32 + 8 * g4 + 4 * h;
      const uint2 rw = *(const uint2*)(P + m * PW + 2464 + hh * 64 + e0);
      const float rv[4] = {__uint_as_float(rw.x << 16), __uint_as_float(rw.x & 0xffff0000u), __uint_as_float(rw.y << 16), __uint_as_float(rw.y & 0xffff0000u)};
      float ov[4];
#pragma unroll
      for (int q = 0; q < 4; ++q) ov[q] = accO[4 * g4 + q] * rstd * ng[e0 + q] * (rv[q] * __builtin_amdgcn_rcpf(1.f + __expf(-rv[q])));
      uint2 pk; pk.x = pack2(ov[0], ov[1]); pk.y = pack2(ov[2], ov[3]);
      *(uint2*)(O + m * DM + 512 + hh * 64 + e0) = pk;
    }
  }
}

DI void shifted_load8(const bfr* P, int m, int t, int col, const float* mu, float (&o)[8]) {
  const bfr* row = P + (size_t)m * PW + col;
  const bool hp = (t != 0 && t != TL), hn = (t != TL - 1 && t != TT - 1);
  const u32x4 cur = *(const u32x4*)row;
  u32x4 prv = {0u, 0u, 0u, 0u}, nxt = {0u, 0u, 0u, 0u};
  if (hp) prv = *(const u32x4*)(row - PW);
  if (hn) nxt = *(const u32x4*)(row + PW);
  float x[8], xp[8], xn[8], m0v[8], m1v[8];
  unpack8(cur, x); unpack8(prv, xp); unpack8(nxt, xn);
  load8f(mu + col, m0v); load8f(mu + 1152 + col, m1v);
#pragma unroll
  for (int e = 0; e < 8; ++e) o[e] = x[e] + m0v[e] * (xp[e] - x[e]) + m1v[e] * (xn[e] - x[e]);
}

DN void rw_finish_tile(const Params& p, int l, int tile, char* smem) {
  const bfr* P = (const bfr*)(p.ws + OFF_P);
  const bfr* RWIN = (const bfr*)(p.ws + OFF_RWIN);
  const bfr* Y0 = (const bfr*)(p.ws + OFF_RWY);
  const bfr* Y1 = Y0 + (size_t)MR * 256;
  bfr* O = (bfr*)(p.ws + OFF_HO);
  const float* mu = p.in[oidx(10)] + (size_t)l * 2 * 1152;
  const int tid = otid();
  const int c0 = (tid & 31) * 8;
  float lng[8], lnb[8], rk[8], kaw[8];
  load8f(p.in[oidx(19)] + l * 256 + c0, lng); load8f(p.in[oidx(20)] + l * 256 + c0, lnb);
  load8f(p.in[oidx(18)] + l * 256 + c0, rk); load8f(p.in[oidx(17)] + l * 256 + c0, kaw);
#pragma unroll 1
  for (int ps = 0; ps < 2; ++ps) {
    const int m = tile * 16 + ps * 8 + (tid >> 5), t = m % TT;
    float y0[8], y1[8], af[8], ab[8], gt[8], rr[8], kx[8], vx[8];
    unpack8(*(const u32x4*)(Y0 + (size_t)m * 256 + c0), y0);
    unpack8(*(const u32x4*)(Y1 + (size_t)m * 256 + c0), y1);
    unpack8(*(const u32x4*)(RWIN + ((size_t)2 * MR + m) * 256 + c0), af);
    unpack8(*(const u32x4*)(RWIN + ((size_t)3 * MR + m) * 256 + c0), ab);
    unpack8(*(const u32x4*)(RWIN + ((size_t)4 * MR + m) * 256 + c0), gt);
    shifted_load8(P, m, t, c0, mu, rr);
    shifted_load8(P, m, t, 256 + c0, mu, kx);
    shifted_load8(P, m, t, 512 + c0, mu, vx);
    float sy = 0.f;
#pragma unroll
    for (int e = 0; e < 8; ++e) { y0[e] += y1[e]; sy += y0[e]; }
    const float mean = red8(sy) * (1.f / 64.f);
    float sv = 0.f, sd = 0.f;
#pragma unroll
    for (int e = 0; e < 8; ++e) {
      const float dl = y0[e] - mean; y0[e] = dl; sv += dl * dl;
      const float kds = kx[e] * (1.f + (af[e] - 1.f) * kaw[e]) + kx[e] * (1.f + (ab[e] - 1.f) * kaw[e]);
      sd += rr[e] * rk[e] * kds;
    }
    const float var = red8(sv) * (1.f / 64.f);
    const float sdot = red8(sd);
    const float rs = rsqrtf(var + 64e-5f);
    float ov[8];
#pragma unroll
    for (int e = 0; e < 8; ++e) ov[e] = (y0[e] * rs * lng[e] + lnb[e] + sdot * vx[e]) * gt[e];
    u32x4 ow; ow.x = pack2(ov[0], ov[1]); ow.y = pack2(ov[2], ov[3]); ow.z = pack2(ov[4], ov[5]); ow.w = pack2(ov[6], ov[7]);
    *(u32x4*)(O + (size_t)m * DM + c0) = ow;
  }
}

#define GSYNC() do { \
    asm volatile("s_waitcnt vmcnt(0)" ::: "memory");     \
    __syncthreads(); \
    gs_target += gridDim.x; \
    if (threadIdx.x == 0) { \
      unsigned* gbar_ = (unsigned*)(p.ws + OFF_CTR) + 32; \
      __builtin_amdgcn_fence(__ATOMIC_RELEASE, "agent"); \
      __hip_atomic_fetch_add(gbar_, 1u, __ATOMIC_RELAXED, __HIP_MEMORY_SCOPE_AGENT); \
      while ((int)(__hip_atomic_load(gbar_, __ATOMIC_RELAXED, __HIP_MEMORY_SCOPE_AGENT) - gs_target) < 0) __builtin_amdgcn_s_sleep(1); \
      __builtin_amdgcn_fence(__ATOMIC_ACQUIRE, "agent"); \
      asm volatile("s_waitcnt vmcnt(0)" ::: "memory");     \
    } \
    __syncthreads(); \
  } while (0)
#define EXP_G 1
__global__ void __launch_bounds__(512, 2) fwd_megakernel(Params p) {
  cg::grid_group grid = cg::this_grid();
  unsigned gs_target = 0;
  if (threadIdx.x < 8) ((int*)(dynlds + LDS_MISC_OFF))[threadIdx.x] = 0;
  __syncthreads();
#define smem ((char*)dynlds + vhalf() * 65536)
#define s_item ((volatile int*)(dynlds + LDS_MISC_OFF) + 4 + vhalf())
#define ctr ((unsigned*)(p.ws + OFF_CTR))

  convert_weights(p, 0, smem);
  compute_mod(p, smem);
  compute_rope(p);
  if (blockIdx.x == 0 && threadIdx.x < 24) ctr[threadIdx.x] = 0u;
  if (blockIdx.x == 0 && threadIdx.x == 32) ctr[32] = 0u;
  grid.sync();

#pragma unroll 1
  for (int l = 0; l < 2; ++l) {
    const bool need_ctx = (l == 0);
    if (l == 1) convert_weights(p, 1, smem);
#pragma unroll 1
    for (int r2 = 0; r2 < EXP_G; ++r2) {
    norm_phase(p, l, 0, l == 0, false);
    GSYNC();
    phase_g1(p);
    GSYNC();
    }
    phase_prep(p, l, smem);
    GSYNC();
#pragma unroll 1
    for (int r2 = 0; r2 < EXP_G; ++r2) {
    phase_lora(p, l);
    GSYNC();
    }
#ifndef EXP_MIX
#define EXP_MIX 1
#define EXP_MODE 1
#define EXP_TOTAL (n_rw)
#define EXP_FIN 1
#endif
#pragma unroll 1
    for (int rep = 0; rep < EXP_MIX; ++rep) {
      const int n_rw = 128, n_gla = 64, n_da = 512, n_gq = 512;
      const int n_dac = need_ctx ? 64 : 0, n_gqc = need_ctx ? 64 : 0;
      const int total = n_gla + n_da + n_gq + n_dac + n_gqc;
      for (int it = blockIdx.x; it < n_rw; it += gridDim.x) rw_scan_item(p, l, it, need_ctx, rep == 0 ? 0 : EXP_MODE);
      volatile int* s_blk = (volatile int*)(dynlds + LDS_MISC_OFF) + 8;
      const int xcd = (int)(__builtin_amdgcn_s_getreg((3 << 11) | 20) & 7u);
      const int QL = 136 + (need_ctx ? 16 : 0);
      int xo = 0;
      (void)total;
      for (;;) {
        __syncthreads();
        if (threadIdx.x == 0) {
          int got = -1, gq_ = 0;
          while (xo < 8) {
            const int q = (xcd + xo) & 7;
            const int k = (int)atomicAdd(&ctr[8 + l * 8 + q], 1u);
            if (k < QL) { got = k; gq_ = q; break; }
            ++xo;
          }
          s_blk[0] = got; s_blk[1] = gq_;
        }
        __syncthreads();
        int k = s_blk[0];
        const int q = s_blk[1];
        if (k < 0) break;
        if (k < 8) { gla_state_item(p, l, (k * 8 + q) * 2 + vhalf(), smem); continue; }
        k -= 8;
        if (k < 64) { const int g = (k >> 3) * 8 + q, qt = k & 7, b = g >> 2, hd = g & 3; da_item(p, l, b, hd, qt * 256, 0, 36, smem); continue; }
        k -= 64;
        if (k < 64) { const int g = (k >> 4) * 8 + q, sub = k & 15, b = g >> 1, hq = (g & 1) * 2 + (sub >> 3), qt = sub & 7; gqa_item(p, b, hq, qt * 256, 0, 36, smem); continue; }
        k -= 64;
        if (k < 8) { const int e = k * 8 + q, hd = e & 3, b = e >> 2; da_item(p, l, b, hd, TL, TL, 4, smem); continue; }
        k -= 8;
        { const int e = k * 8 + q, hq = e & 3, b = e >> 2; gqa_item(p, b, hq, TL, TL, 4, smem); }
      }
    }
    GSYNC();
#ifndef EXP_FIN
#define EXP_FIN 1
#endif
#pragma unroll 1
    for (int repf = 0; repf < EXP_FIN; ++repf) {
      const int n_rwf = MR / 16;
      const int n_glaf = NB * 36 * 4;
      for (int it = VB(); it < n_rwf + n_glaf; it += NVB()) {
        if (it < n_rwf) {
          int m0 = it * 16;
          if (!need_ctx && (m0 % TT) >= TL) continue;
          rw_finish_tile(p, l, it, smem);
        } else {
          int i2 = it - n_rwf;
          int hh = i2 & 3, cs = (i2 >> 2) % 36, b = (i2 >> 2) / 36;
          if (!need_ctx && cs >= 32) continue;
          gla_finish_item(p, l, b, cs, hh, smem);
        }
      }
    }
    GSYNC();
    phase_resid_gemm(p, l, (const bfr*)(p.ws + OFF_HO), (const bfr*)(p.ws + OFF_WOUT), DM, 2, l == 0, !need_ctx);
    GSYNC();
#pragma unroll 1
    for (int r2 = 0; r2 < EXP_G; ++r2) {
    norm_phase(p, l, 1, false, !need_ctx);
    GSYNC();
    phase_g3(p, l, !need_ctx);
    GSYNC();
    }
    fix_own_tiles(p, l, !need_ctx);
    phase_resid_gemm(p, l, (const bfr*)(p.ws + OFF_A2), (const bfr*)(p.ws + OFF_WDN), DFF, 5, false, !need_ctx);
    GSYNC();
  }
}

extern "C" void kernel_launch(void* const* d_in, const int* in_sizes, int n_in,
                              void* d_out, int out_size, void* d_ws, size_t ws_size,
                              hipStream_t stream) {
  static int grid_blocks = 0;
  if (!grid_blocks) {
    int dev = 0, cus = 0, per_cu = 0;
    (void)hipGetDevice(&dev);
    (void)hipDeviceGetAttribute(&cus, hipDeviceAttributeMultiprocessorCount, dev);
    if (hipFuncSetAttribute((const void*)fwd_megakernel, hipFuncAttributeMaxDynamicSharedMemorySize, LDS_BYTES) != hipSuccess)
      fprintf(stderr, "hipFuncSetAttribute failed\n");
    (void)hipOccupancyMaxActiveBlocksPerMultiprocessor(&per_cu, fwd_megakernel, 512, LDS_BYTES);
    (void)hipGetLastError();
    grid_blocks = cus;
  }
  Params p{};
  for (int i = 0; i < 32; ++i) p.in[i] = (const float*)d_in[i];
  p.out = (float*)d_out;
  p.ws = (char*)d_ws;
  void* args[] = {&p};
  hipError_t e = hipLaunchCooperativeKernel((void*)fwd_megakernel, dim3(grid_blocks), dim3(512), args, LDS_BYTES, stream);
  if (e != hipSuccess) fprintf(stderr, "cooperative launch failed: %s (grid %d)\n", hipGetErrorString(e), grid_blocks);
}
```

```cpp
#include <hip/hip_runtime.h>
#include <hip/hip_bf16.h>
#include <hip/hip_cooperative_groups.h>
#include <cstdio>
namespace cg = cooperative_groups;

#define DI __device__ __forceinline__
#define DN __device__ __forceinline__
#define LAS __attribute__((address_space(3)))
extern __shared__ __attribute__((aligned(16))) unsigned char dynlds[];
constexpr int LDS_RING = 131072, LDS_BD_OFF = 131072, LDS_MISC_OFF = 131072 + 4096, LDS_PARAMS_OFF = 131072 + 4096 + 256, LDS_BYTES = 131072 + 4096 + 256 + 512;
DI int otid() { int t = threadIdx.x & 255; asm volatile("" : "+v"(t)); return t; }
DI int oidx(int i) { asm volatile("" : "+s"(i)); return i; }
DI int vhalf() { int h = __builtin_amdgcn_readfirstlane(threadIdx.x >> 8); asm volatile("" : "+s"(h)); return h; }
DI int VB() { return blockIdx.x * 2 + vhalf(); }
DI int NVB() { return gridDim.x * 2; }
DI void vsync() {
  __builtin_amdgcn_fence(__ATOMIC_RELEASE, "workgroup");
  if ((threadIdx.x & 63) == 0) {
    int* bar = (int*)(dynlds + LDS_MISC_OFF) + (threadIdx.x >> 8);
    int old = __hip_atomic_fetch_add(bar, 1, __ATOMIC_RELAXED, __HIP_MEMORY_SCOPE_WORKGROUP);
    int tgt = (old & ~3) + 4;
    while (__hip_atomic_load(bar, __ATOMIC_RELAXED, __HIP_MEMORY_SCOPE_WORKGROUP) - tgt < 0) __builtin_amdgcn_s_sleep(1);
  }
  __builtin_amdgcn_fence(__ATOMIC_ACQUIRE, "workgroup");
}
typedef unsigned short bfr;
typedef __attribute__((ext_vector_type(8))) short bf16x8;
typedef __attribute__((ext_vector_type(4))) short s16x4;
typedef __attribute__((ext_vector_type(16))) float f32x16;
typedef __attribute__((ext_vector_type(4))) unsigned u32x4;
typedef __attribute__((ext_vector_type(2))) float f32x2;
typedef __attribute__((ext_vector_type(4))) float f32x4v;
#define MFMA32(a, b, c) __builtin_amdgcn_mfma_f32_32x32x16_bf16((a), (b), (c), 0, 0, 0)

constexpr int NB = 16, TL = 2048, TC = 256, TT = 2304, DM = 1024, MR = NB * TT;
constexpr int PW = 3264, NINP = 3328, DFF = 2816;
constexpr int SMEM_BYTES = 55296;

constexpr size_t OFF_WIN = 0;
constexpr size_t SZ_WIN = (size_t)NINP * DM * 2;
constexpr size_t OFF_WOUT = OFF_WIN + SZ_WIN;
constexpr size_t SZ_WOUT = (size_t)DM * DM * 2;
constexpr size_t OFF_WUP = OFF_WOUT + SZ_WOUT;
constexpr size_t SZ_WUP = (size_t)2 * DFF * DM * 2;
constexpr size_t OFF_WDN = OFF_WUP + SZ_WUP;
constexpr size_t SZ_WDN = (size_t)DM * DFF * 2;
constexpr size_t OFF_WLORA = OFF_WDN + SZ_WDN;
constexpr size_t SZ_WLORA = (size_t)1280 * 384 * 2;
constexpr size_t OFF_MOD = OFF_WLORA + SZ_WLORA;
constexpr size_t SZ_MOD = (size_t)2 * 17 * 6144 * 4;
constexpr size_t OFF_XC = OFF_MOD + SZ_MOD;
constexpr size_t SZ_XC = (size_t)NB * TC * DM * 4;
constexpr size_t OFF_ROPE = OFF_XC + SZ_XC;
constexpr size_t SZ_ROPE = (size_t)TL * 96 * 4;
constexpr size_t OFF_CTR = OFF_ROPE + SZ_ROPE;
constexpr size_t SZ_CTR = 256;
constexpr size_t OFF_HO = OFF_CTR + SZ_CTR;
constexpr size_t SZ_HO = (size_t)MR * DM * 2;
constexpr size_t OFF_P = OFF_HO + SZ_HO;
constexpr size_t SZ_P = (size_t)MR * PW * 2;
constexpr size_t OFF_RWIN = OFF_P + SZ_P;
constexpr size_t SZ_RWIN = (size_t)5 * MR * 256 * 2;
constexpr size_t OFF_RWY = OFF_RWIN + SZ_RWIN;
constexpr size_t SZ_RWY = (size_t)2 * MR * 256 * 2;
constexpr size_t OFF_GS = OFF_RWY + SZ_RWY;
constexpr size_t SZ_GS = (size_t)NB * 36 * 4 * 2 * 2048 * 4;
constexpr size_t WS_TOTAL = OFF_GS + SZ_GS;
static_assert(WS_TOTAL <= (size_t)536870912, "workspace too large");
constexpr size_t OFF_A2 = OFF_P;
constexpr size_t OFF_EDGE = OFF_RWIN;

struct Params {
  const float* in[32];
  float* out;
  char* ws;
};

DI void vsync_l() {
  asm volatile("s_waitcnt lgkmcnt(0)" ::: "memory");
  if ((threadIdx.x & 63) == 0) {
    int* bar = (int*)(dynlds + LDS_MISC_OFF) + (threadIdx.x >> 8);
    int old = __hip_atomic_fetch_add(bar, 1, __ATOMIC_RELAXED, __HIP_MEMORY_SCOPE_WORKGROUP);
    int tgt = (old & ~3) + 4;
    while (__hip_atomic_load(bar, __ATOMIC_RELAXED, __HIP_MEMORY_SCOPE_WORKGROUP) - tgt < 0) __builtin_amdgcn_s_sleep(1);
  }
  asm volatile("" ::: "memory");
}
DI bfr f2bf(float x) { unsigned u = __float_as_uint(x); u += 0x7fffu + ((u >> 16) & 1u); return (bfr)(u >> 16); }
DI float bf2f(bfr u) { return __uint_as_float(((unsigned)u) << 16); }
DI unsigned pack2(float a, float b) { unsigned r; asm volatile("v_cvt_pk_bf16_f32 %0, %1, %2" : "=v"(r) : "v"(a), "v"(b)); return r; }
template <int CTRL> DI float dppf(float x) {
  return __builtin_bit_cast(float, __builtin_amdgcn_mov_dpp(__builtin_bit_cast(int, x), CTRL, 0xf, 0xf, true));
}
DI float wave_sum(float v) {
  v += dppf<0xB1>(v); v += dppf<0x4E>(v); v += dppf<0x141>(v); v += dppf<0x140>(v);
  const float r0 = __builtin_bit_cast(float, __builtin_amdgcn_readlane(__builtin_bit_cast(int, v), 0));
  const float r1 = __builtin_bit_cast(float, __builtin_amdgcn_readlane(__builtin_bit_cast(int, v), 16));
  const float r2 = __builtin_bit_cast(float, __builtin_amdgcn_readlane(__builtin_bit_cast(int, v), 32));
  const float r3 = __builtin_bit_cast(float, __builtin_amdgcn_readlane(__builtin_bit_cast(int, v), 48));
  return (r0 + r1) + (r2 + r3);
}
DI float red8(float x) { x += dppf<0xB1>(x); x += dppf<0x4E>(x); x += dppf<0x141>(x); return x; }
DI float sigmoidf_(float x) { return 1.f / (1.f + expf(-x)); }
DI float softplusf_(float z) { return fmaxf(z, 0.f) + log1pf(expf(-fabsf(z))); }

DI const float* in_row(const Params& p, int b, int t) {
  return t < TL ? p.in[oidx(0)] + ((size_t)b * TL + t) * DM : p.in[oidx(2)] + ((size_t)b * TC + (t - TL)) * DM;
}
DI float* res_row(const Params& p, int b, int t) {
  return t < TL ? p.out + ((size_t)b * TL + t) * DM : (float*)(p.ws + OFF_XC) + ((size_t)b * TC + (t - TL)) * DM;
}

DN void convert_weights(const Params& p, int l, char* smem) {
  float* tile68 = (float*)smem;
  const int tid = otid();
  const int T_IN = 52 * 16, T_OUT = 16 * 16, T_UP = 88 * 16, T_DN = 16 * 44;
  const int total = T_IN + T_OUT + T_UP + T_DN;
  for (int it = VB(); it < total; it += NVB()) {
    const float* src; int ld, ldd, n0, k0, mode, nvalid; bfr* dst;
    if (it < T_IN) { int nt = it / 16, kt = it % 16; src = p.in[oidx(8)] + (size_t)l * DM * 3232; ld = 3232; nvalid = 3232; dst = (bfr*)(p.ws + OFF_WIN); ldd = DM; n0 = nt * 64; k0 = kt * 64; mode = 0; }
    else if (it < T_IN + T_OUT) { int i2 = it - T_IN; int nt = i2 / 16, kt = i2 % 16; src = p.in[oidx(9)] + (size_t)l * DM * DM; ld = DM; nvalid = DM; dst = (bfr*)(p.ws + OFF_WOUT); ldd = DM; n0 = nt * 64; k0 = kt * 64; mode = 0; }
    else if (it < T_IN + T_OUT + T_UP) { int i2 = it - T_IN - T_OUT; int nt = i2 / 16, kt = i2 % 16; src = p.in[oidx(28)] + (size_t)l * DM * 2 * DFF; ld = 2 * DFF; nvalid = 2 * DFF; dst = (bfr*)(p.ws + OFF_WUP); ldd = DM; n0 = nt * 64; k0 = kt * 64; mode = 1; }
    else { int i2 = it - T_IN - T_OUT - T_UP; int nt = i2 / 44, kt = i2 % 44; src = p.in[oidx(31)] + (size_t)l * DFF * DM; ld = DM; nvalid = DM; dst = (bfr*)(p.ws + OFF_WDN); ldd = DFF; n0 = nt * 64; k0 = kt * 64; mode = 0; }
#pragma unroll
    for (int i = 0; i < 4; ++i) {
      const int c = tid + 256 * i, kl = c >> 4, n4 = (c & 15) * 4;
      const int n = n0 + n4;
      int sc = n;
      if (mode == 1) { int grp = n >> 8, within = n & 255; sc = ((within >= 128) ? DFF : 0) + grp * 128 + (within & 127); }
      f32x4v v = {0.f, 0.f, 0.f, 0.f};
      if (sc < nvalid) v = *(const f32x4v*)(src + (size_t)(k0 + kl) * ld + sc);
      *(f32x4v*)(&tile68[kl * 68 + n4]) = v;
    }
    vsync();
#pragma unroll
    for (int i = 0; i < 2; ++i) {
      const int c = tid + 256 * i, nl = c & 63, k8 = (c >> 6) * 8;
      float t8[8];
#pragma unroll
      for (int e = 0; e < 8; ++e) t8[e] = tile68[(k8 + e) * 68 + nl];
      u32x4 ow; ow.x = pack2(t8[0], t8[1]); ow.y = pack2(t8[2], t8[3]); ow.z = pack2(t8[4], t8[5]); ow.w = pack2(t8[6], t8[7]);
      *(u32x4*)(dst + (size_t)(n0 + nl) * ldd + k0 + k8) = ow;
    }
    vsync();
  }
  {
    bfr* WL = (bfr*)(p.ws + OFF_WLORA);
    const float* w2 = p.in[oidx(12)] + (size_t)l * 2 * 64 * 256;
    const float* a2 = p.in[oidx(14)] + (size_t)l * 2 * 64 * 256;
    const float* g2 = p.in[oidx(15)] + (size_t)l * 128 * 256;
    for (int i = VB() * 256 + tid; i < 1280 * 384; i += NVB() * 256) {
      int n = i / 384, k = i - n * 384;
      int kind = n >> 8, c = n & 255;
      float v = 0.f;
      if (kind < 4) { int kb = k - kind * 64; if (kb >= 0 && kb < 64 && k < 256) v = (kind < 2) ? w2[((size_t)kind * 64 + kb) * 256 + c] : a2[((size_t)(kind - 2) * 64 + kb) * 256 + c]; }
      else { if (k >= 256) v = g2[(size_t)(k - 256) * 256 + c]; }
      WL[i] = f2bf(v);
    }
  }
}

DN void compute_mod(const Params& p, char* smem) {
  float* sc = (float*)smem;
  float* red = sc + 17 * 256;
  const int tid = otid();
  float* MOD = (float*)(p.ws + OFF_MOD);
  for (int it = VB(); it < 192; it += NVB()) {
    int l = it / 96, nb = it % 96;
    int col = nb * 64 + (tid & 63), kg = tid >> 6;
    const float* W = p.in[oidx(4)] + (size_t)l * DM * 6144;
    float acc[17];
#pragma unroll
    for (int r = 0; r < 17; ++r) acc[r] = 0.f;
    for (int kc = 0; kc < 4; ++kc) {
      vsync();
      for (int i = tid; i < 17 * 256; i += 256) {
        int r = i >> 8, k = i & 255;
        float c = (r < 16) ? p.in[oidx(1)][r * DM + kc * 256 + k] : p.in[oidx(3)][kc * 256 + k];
        sc[i] = c / (1.f + expf(-c));
      }
      vsync();
#pragma unroll 1
      for (int kk0 = 0; kk0 < 64; kk0 += 16) {
        float wv[16];
#pragma unroll
        for (int u = 0; u < 16; ++u) wv[u] = W[(size_t)(kc * 256 + kg * 64 + kk0 + u) * 6144 + col];
#pragma unroll
        for (int u = 0; u < 16; ++u) {
#pragma unroll
          for (int r = 0; r < 17; ++r) acc[r] += sc[r * 256 + kg * 64 + kk0 + u] * wv[u];
        }
      }
    }
    vsync();
#pragma unroll
    for (int r = 0; r < 17; ++r) red[(kg * 17 + r) * 64 + (tid & 63)] = acc[r];
    vsync();
    for (int i = tid; i < 17 * 64; i += 256) {
      int r = i >> 6, cl = i & 63;
      float s = red[(0 * 17 + r) * 64 + cl] + red[(1 * 17 + r) * 64 + cl] + red[(2 * 17 + r) * 64 + cl] + red[(3 * 17 + r) * 64 + cl];
      MOD[(size_t)(l * 17 + r) * 6144 + nb * 64 + cl] = s + p.in[oidx(5)][l * 6144 + nb * 64 + cl];
    }
  }
}

DN void compute_rope(const Params& p) {
  float* rope = (float*)(p.ws + OFF_ROPE);
  const int gtid = VB() * 256 + otid(), gsz = NVB() * 256;
  for (int i = gtid; i < TL * 48; i += gsz) {
    int t = i / 48, e = i % 48;
    int row = t >> 6, col = t & 63;
    int nf, idx;
    if (e < 16) { nf = 8; idx = e; } else { nf = 16; idx = e - 16; }
    int fi = idx % nf;
    float pos = (idx < nf) ? (float)row : (float)col;
    float inv = exp2f(-(float)fi / (float)nf * 13.287712379549449f);
    float ang = pos * inv;
    float cs = cosf(ang), sn = sinf(ang);
    if (e < 16) { rope[t * 96 + e] = cs; rope[t * 96 + 16 + e] = sn; }
    else { rope[t * 96 + 32 + idx] = cs; rope[t * 96 + 64 + idx] = sn; }
  }
}

DN void norm_phase(const Params& p, int l, int which, bool from_input, bool skip_ctx) {
  const int tid = otid(), lane = tid & 63;
  const int wave = (VB() * 256 + tid) >> 6, nw = NVB() * 4;
  const float* g = p.in[oidx(6) + which] + l * DM;
  const float* MOD = (const float*)(p.ws + OFF_MOD);
  bfr* H = (bfr*)(p.ws + OFF_HO);
  for (int m0 = wave * 4; m0 < MR; m0 += nw * 4) {
    f32x4v v[4][4];
    float ss[4];
    bool act[4];
    const float* modp[4];
#pragma unroll
    for (int q = 0; q < 4; ++q) {
      const int m = m0 + q;
      const int b = m / TT, t = m - b * TT;
      const bool isctx = t >= TL;
      act[q] = !(isctx && skip_ctx);
      const float* src = from_input ? in_row(p, b, t) : res_row(p, b, t);
      modp[q] = MOD + (size_t)(l * 17 + (isctx ? 16 : b)) * 6144;
      ss[q] = 0.f;
      if (act[q]) {
#pragma unroll
        for (int i = 0; i < 4; ++i) {
          v[q][i] = *(const f32x4v*)(src + i * 256 + lane * 4);
          ss[q] += v[q][i].x * v[q][i].x + v[q][i].y * v[q][i].y + v[q][i].z * v[q][i].z + v[q][i].w * v[q][i].w;
        }
      } else {
#pragma unroll
        for (int i = 0; i < 4; ++i) v[q][i] = (f32x4v){0.f, 0.f, 0.f, 0.f};
      }
    }
#pragma unroll
    for (int q = 0; q < 4; ++q) {
      if (!act[q]) continue;
      const int m = m0 + q;
      const float* shift = modp[q] + (which ? 3 : 0) * DM;
      const float* scale = modp[q] + (which ? 4 : 1) * DM;
      const float tot = wave_sum(ss[q]);
      const float rstd = rsqrtf(tot * (1.f / DM) + 1e-6f);
#pragma unroll
      for (int i = 0; i < 4; ++i) {
        const int k = i * 256 + lane * 4;
        const f32x4v gg = *(const f32x4v*)(g + k), sc = *(const f32x4v*)(scale + k), sh = *(const f32x4v*)(shift + k);
        const float o0 = (v[q][i].x * rstd * gg.x) * (1.f + sc.x) + sh.x;
        const float o1 = (v[q][i].y * rstd * gg.y) * (1.f + sc.y) + sh.y;
        const float o2 = (v[q][i].z * rstd * gg.z) * (1.f + sc.z) + sh.z;
        const float o3 = (v[q][i].w * rstd * gg.w) * (1.f + sc.w) + sh.w;
        uint2 pk; pk.x = pack2(o0, o1); pk.y = pack2(o2, o3);
        *(uint2*)(H + (size_t)m * DM + k) = pk;
      }
    }
  }
}

namespace pg8 {
#define PG8_LAS __attribute__((address_space(3)))
typedef unsigned short bf16_t;
typedef short bf16x8 __attribute__((ext_vector_type(8)));
typedef float f32x4 __attribute__((ext_vector_type(4)));
typedef unsigned u32x4 __attribute__((ext_vector_type(4)));
constexpr int BM = 256, BK = 64, HALF = 128, HTB = HALF * BK * 2  , STAGE_BYTES = 8 * HTB, NXCD = 8, WGM = 8;

__host__ __device__ __forceinline__ int lds_byte(int r, int c) { const int st = (r >> 4) * 2 + (c >> 5), rr = r & 15, cc = c & 31, ob = rr * 64 + cc * 2; return st * 1024 + (ob ^ (((ob >> 9) & 1) << 5)); }
__host__ __device__ __forceinline__ void stage_rc(int b, int& R, int& C) { const int st = b / 1024, sb = b % 1024, swz = sb ^ (((sb >> 9) & 1) << 5); R = (st >> 1) * 16 + swz / 64; C = (st & 1) * 32 + (swz % 64) / 2; }
__host__ __device__ __forceinline__ int perm32(int rho) { const int n = rho >> 4, i = rho & 15; return 8 * (i >> 2) + 4 * n + (i & 3); }

struct Unit { int pm, pn; int kofs = 0; };
struct Gemm { const bf16_t* A; const bf16_t* Bt; int M, N, K; int ntov = 0; };

__device__ __forceinline__ unsigned cvt_pk_bf16(float lo, float hi) { unsigned r; asm volatile("v_cvt_pk_bf16_f32 %0, %1, %2" : "=v"(r) : "v"(lo), "v"(hi)); return r; }
template <class Epi, class Sched, bool ALIGN_EPI = false, bool SP2 = false>
__device__ __forceinline__ void gemm_phase(PG8_LAS unsigned char* lds, const Gemm g, const Sched& S, const Epi& E) {
    int tid_ = threadIdx.x; asm volatile("" : "+v"(tid_));
    const int tid = tid_, wid = __builtin_amdgcn_readfirstlane(tid >> 6), lane = tid & 63, wr = wid >> 2, wc = wid & 3, fr = lane & 15, fq = lane >> 4;
    const int K = g.K, nt = g.ntov ? g.ntov : K / BK;
    unsigned voffA[2], voffB[2];
#pragma unroll
    for (int i = 0; i < 2; ++i) { int R, C; stage_rc(tid * 16 + i * 8192, R, C); const int Rb = Epi::PERM ? ((R & ~31) + perm32(R & 31)) : R;
        voffA[i] = (unsigned)(R * K + C) * 2u; voffB[i] = (unsigned)(Rb * K + C) * 2u; }
    const size_t kstep = (size_t)(BK * 2);
    const size_t hstep = (size_t)HALF * K * 2;
    const size_t tstep = 2 * hstep;
    const unsigned ldsw = (unsigned)wid * 1024u;
    const int aoff = lds_byte(wr * 64 + fr, fq * 8), boff = lds_byte(wc * 32 + fr, fq * 8);
#define PG8_SA(b, h) (((b) * 2 + (h)) * HTB)
#define PG8_SB(b, h) ((4 + (b) * 2 + (h)) * HTB)
#define PG8_STAGE(bufoff, gbase, voff) do { _Pragma("unroll") for (int _i = 0; _i < 2; ++_i) \
        __builtin_amdgcn_global_load_lds((const unsigned*)((const char*)(gbase) + (voff)[_i]), (PG8_LAS unsigned*)(lds + (bufoff) + ldsw + _i * 8192), 16, 0, 0); } while (0)
#define PG8_LDA(dst, b, h) do { _Pragma("unroll") for (int m = 0; m < 4; ++m) _Pragma("unroll") for (int k = 0; k < 2; ++k) dst[m][k] = *(const PG8_LAS bf16x8*)(lds + PG8_SA(b, h) + aoff + m * 2048 + k * 1024); } while (0)
#define PG8_LDB(dst, b, h) do { _Pragma("unroll") for (int n = 0; n < 2; ++n) _Pragma("unroll") for (int k = 0; k < 2; ++k) dst[n][k] = *(const PG8_LAS bf16x8*)(lds + PG8_SB(b, h) + boff + n * 2048 + k * 1024); } while (0)
#define PG8_MMA(ai, bj, At, Bt) do { __builtin_amdgcn_s_setprio(1); _Pragma("unroll") for (int m = 0; m < 4; ++m) _Pragma("unroll") for (int n = 0; n < 2; ++n) _Pragma("unroll") for (int k = 0; k < 2; ++k) \
        acc[ai][bj][m][n] = __builtin_amdgcn_mfma_f32_16x16x32_bf16(Bt[n][k], At[m][k], acc[ai][bj][m][n], 0, 0, 0); __builtin_amdgcn_s_setprio(0); } while (0)
#define PG8_WAIT_V(n) asm volatile("s_waitcnt vmcnt(" #n ")" ::: "memory")
#define PG8_WAIT_L(n) asm volatile("s_waitcnt lgkmcnt(" #n ")" ::: "memory")
#define PG8_BAR __builtin_amdgcn_s_barrier()
#define PG8_SCHED __builtin_amdgcn_sched_barrier(0)
    Unit cur, nxt; int ui = 0;
    if (!S.next(0, cur)) return;
    f32x4 acc[2][2][4][2];
#pragma unroll
    for (int a = 0; a < 2; ++a)
#pragma unroll
        for (int b = 0; b < 2; ++b)
#pragma unroll
            for (int m = 0; m < 4; ++m)
#pragma unroll
                for (int n = 0; n < 2; ++n) acc[a][b][m][n] = (f32x4){0.f, 0.f, 0.f, 0.f};
    bf16x8 At[4][2], B0[2][2], B1[2][2];
    const char* cA = (const char*)g.A + (size_t)cur.pm * tstep + 2 * cur.kofs; const char* cB = (const char*)g.Bt + (size_t)cur.pn * tstep + 2 * cur.kofs;
    S.a_ready(cur);
    if constexpr (SP2) {
        PG8_STAGE(PG8_SB(0, 0), cB, voffB); PG8_STAGE(PG8_SB(0, 1), cB + hstep, voffB); PG8_STAGE(PG8_SA(0, 0), cA, voffA); PG8_STAGE(PG8_SA(0, 1), cA + hstep, voffA);
        if (wr == 1) PG8_BAR;
        PG8_WAIT_V(2); PG8_BAR;
        PG8_STAGE(PG8_SB(1, 0), cB + kstep, voffB); PG8_STAGE(PG8_SA(1, 0), cA + kstep, voffA); PG8_STAGE(PG8_SB(1, 1), cB + hstep + kstep, voffB);
        PG8_WAIT_V(6); PG8_BAR;
    } else {
        PG8_STAGE(PG8_SB(0, 0), cB, voffB); PG8_STAGE(PG8_SA(0, 0), cA, voffA); PG8_STAGE(PG8_SB(0, 1), cB + hstep, voffB); PG8_STAGE(PG8_SA(0, 1), cA + hstep, voffA);
        if (wr == 1) PG8_BAR;
        PG8_WAIT_V(4); PG8_BAR;
        PG8_STAGE(PG8_SB(1, 0), cB + kstep, voffB); PG8_STAGE(PG8_SA(1, 0), cA + kstep, voffA); PG8_STAGE(PG8_SB(1, 1), cB + hstep + kstep, voffB);
        PG8_WAIT_V(6); PG8_BAR;
    }
    for (;;) {
        const bool has_next = S.next(ui + 1, nxt);
        const char* nA = has_next ? (const char*)g.A + (size_t)nxt.pm * tstep + 2 * nxt.kofs : cA; const char* nB = has_next ? (const char*)g.Bt + (size_t)nxt.pn * tstep + 2 * nxt.kofs : cB;
        for (int t = 0; t < nt; t += 2) {
            const bool last = (t == nt - 2);
            const char* a1 = cA + (size_t)(t + 1) * kstep;
            const char* a2 = last ? nA : cA + (size_t)(t + 2) * kstep; const char* b2 = last ? nB : cB + (size_t)(t + 2) * kstep;
            const char* a3 = a2 + kstep; const char* b3 = b2 + kstep;
            if (last && has_next) S.a_ready(nxt);
            if constexpr (SP2) {
            PG8_LDB(B0, 0, 0); PG8_LDB(B1, 0, 1); PG8_SCHED; PG8_LDA(At, 0, 0); PG8_STAGE(PG8_SA(1, 1), a1 + hstep, voffA);
            PG8_WAIT_V(8); PG8_WAIT_L(0); PG8_BAR; PG8_MMA(0, 0, At, B0); PG8_MMA(0, 1, At, B1); PG8_BAR; PG8_SCHED;
            PG8_LDA(At, 0, 1); PG8_STAGE(PG8_SB(0, 0), b2, voffB); PG8_STAGE(PG8_SB(0, 1), b2 + hstep, voffB); PG8_STAGE(PG8_SA(0, 0), a2, voffA);
            PG8_WAIT_V(8); PG8_WAIT_L(0); PG8_BAR; PG8_MMA(1, 0, At, B0); PG8_MMA(1, 1, At, B1); PG8_BAR; PG8_SCHED;
            PG8_LDB(B0, 1, 0); PG8_LDB(B1, 1, 1); PG8_SCHED; PG8_LDA(At, 1, 0); PG8_STAGE(PG8_SA(0, 1), a2 + hstep, voffA);
            PG8_WAIT_V(8); PG8_WAIT_L(0); PG8_BAR; PG8_MMA(0, 0, At, B0); PG8_MMA(0, 1, At, B1); PG8_BAR; PG8_SCHED;
            PG8_LDA(At, 1, 1); PG8_STAGE(PG8_SB(1, 0), b3, voffB); PG8_STAGE(PG8_SB(1, 1), b3 + hstep, voffB); PG8_STAGE(PG8_SA(1, 0), a3, voffA);
            PG8_WAIT_V(8); PG8_WAIT_L(0); PG8_BAR; PG8_MMA(1, 0, At, B0); PG8_MMA(1, 1, At, B1); PG8_BAR; PG8_SCHED;
            } else {
            PG8_LDB(B0, 0, 0); PG8_SCHED; PG8_LDA(At, 0, 0); PG8_STAGE(PG8_SA(1, 1), a1 + hstep, voffA);
            PG8_WAIT_L(8); PG8_BAR; PG8_WAIT_L(0); PG8_MMA(0, 0, At, B0); PG8_BAR; PG8_SCHED;
            PG8_LDB(B1, 0, 1); PG8_STAGE(PG8_SB(0, 0), b2, voffB);
            PG8_BAR; PG8_WAIT_L(0); PG8_MMA(0, 1, At, B1); PG8_BAR;
            PG8_LDA(At, 0, 1); PG8_STAGE(PG8_SA(0, 0), a2, voffA);
            PG8_BAR; PG8_WAIT_L(0); PG8_MMA(1, 0, At, B0); PG8_BAR; PG8_SCHED;
            PG8_STAGE(PG8_SB(0, 1), b2 + hstep, voffB);
            PG8_WAIT_V(6); PG8_BAR; PG8_MMA(1, 1, At, B1); PG8_BAR;
            PG8_LDB(B0, 1, 0); PG8_SCHED; PG8_LDA(At, 1, 0); PG8_STAGE(PG8_SA(0, 1), a2 + hstep, voffA);
            PG8_WAIT_L(8); PG8_BAR; PG8_WAIT_L(0); PG8_MMA(0, 0, At, B0); PG8_BAR; PG8_SCHED;
            PG8_LDB(B1, 1, 1); PG8_STAGE(PG8_SB(1, 0), b3, voffB);
            PG8_BAR; PG8_WAIT_L(0); PG8_MMA(0, 1, At, B1); PG8_BAR;
            PG8_LDA(At, 1, 1); PG8_STAGE(PG8_SA(1, 0), a3, voffA);
            PG8_BAR; PG8_WAIT_L(0); PG8_MMA(1, 0, At, B0); PG8_BAR; PG8_SCHED;
            PG8_STAGE(PG8_SB(1, 1), b3 + hstep, voffB);
            PG8_WAIT_V(6); PG8_BAR; PG8_MMA(1, 1, At, B1); PG8_BAR;
            }
        }
        if constexpr (ALIGN_EPI) { if (wr == 0) PG8_BAR; }
        if constexpr (!Epi::AFTER_DRAIN) { E(acc, cur, wr, wc, fr, fq); S.done(cur); }
        if (!has_next) break;
#pragma unroll
        for (int a = 0; a < 2; ++a)
#pragma unroll
            for (int b = 0; b < 2; ++b)
#pragma unroll
                for (int m = 0; m < 4; ++m)
#pragma unroll
                    for (int n = 0; n < 2; ++n) acc[a][b][m][n] = (f32x4){0.f, 0.f, 0.f, 0.f};
        cur = nxt; cA = nA; cB = nB; ++ui;
        if constexpr (ALIGN_EPI) { if (wr == 1) PG8_BAR; }
    }
    PG8_WAIT_V(0);
    if constexpr (!ALIGN_EPI) { if (wr == 0) PG8_BAR; }
    PG8_BAR;
    if constexpr (Epi::AFTER_DRAIN) { E.fused(acc, cur, wr, wc, fr, fq, lds, wid, lane); S.done(cur); }
#undef PG8_SA
#undef PG8_SB
#undef PG8_STAGE
#undef PG8_LDA
#undef PG8_LDB
#undef PG8_MMA
#undef PG8_WAIT_V
#undef PG8_WAIT_L
#undef PG8_BAR
#undef PG8_SCHED
}
}

struct MySched {
  int nM, nN, nwg, G, c; bool skip; bool lora = false;
  DI void init(int nM_, int nN_, int G_, int c_, bool skip_) { nM = nM_; nN = nN_; nwg = nM_ * nN_; G = G_; c = c_; skip = skip_; }
  DI bool next(int i, pg8::Unit& u) const {
    const long L = (long)i * G + c; if (L >= nwg) return false;
    int wgid = (int)L; { const int q = nwg / pg8::NXCD, r = nwg % pg8::NXCD, xcd = wgid % pg8::NXCD, off = wgid / pg8::NXCD; wgid = (xcd < r ? xcd * (q + 1) : r * (q + 1) + (xcd - r) * q) + off; }
    const int nig = pg8::WGM * nN, gid = wgid / nig, fm = gid * pg8::WGM, gsz = (nM - fm) < pg8::WGM ? (nM - fm) : pg8::WGM;
    const int pm = fm + ((wgid % nig) % gsz); u.pn = (wgid % nig) / gsz;
    u.pm = skip ? (pm >> 3) * 9 + (pm & 7) : pm;
    u.kofs = lora ? ((u.pn < 4) ? (u.pn >> 1) * 128 : 256) : 0;
    return true;
  }
  DI void a_ready(const pg8::Unit&) const {}
  DI void done(const pg8::Unit&) const {}
};

struct EpiP {
  static constexpr bool PERM = true, AFTER_DRAIN = false;
  bfr* P;
  DI void operator()(const pg8::f32x4 (&acc)[2][2][4][2], const pg8::Unit& u, int wr, int wc, int fr, int fq) const {
    const int row0 = u.pm * 256 + wr * 64 + fr, col0 = u.pn * 256 + wc * 32 + 8 * fq;
#pragma unroll
    for (int ai = 0; ai < 2; ++ai)
#pragma unroll
      for (int m = 0; m < 4; ++m) {
        bfr* rowp = P + (size_t)(row0 + ai * 128 + m * 16) * PW;
#pragma unroll
        for (int bj = 0; bj < 2; ++bj) {
          const int col = col0 + bj * 128;
          if (col < PW) {
            pg8::f32x4 v0 = acc[ai][bj][m][0], v1 = acc[ai][bj][m][1];
            u32x4 w; w.x = pg8::cvt_pk_bf16(v0[0], v0[1]); w.y = pg8::cvt_pk_bf16(v0[2], v0[3]); w.z = pg8::cvt_pk_bf16(v1[0], v1[1]); w.w = pg8::cvt_pk_bf16(v1[2], v1[3]);
            *(u32x4*)(rowp + col) = w;
          }
        }
      }
  }
};

struct EpiResid {
  static constexpr bool PERM = true, AFTER_DRAIN = false;
  const float* xin; const float* cin; float* xout; float* xc; const float* modl; int gi; bool src_input;
  DI void operator()(const pg8::f32x4 (&acc)[2][2][4][2], const pg8::Unit& u, int wr, int wc, int fr, int fq) const {
    const int row0 = u.pm * 256 + wr * 64 + fr, col0 = u.pn * 256 + wc * 32 + 8 * fq;
    const int b = (u.pm * 256) / TT;
#pragma unroll
    for (int ai = 0; ai < 2; ++ai)
#pragma unroll
      for (int m = 0; m < 4; ++m) {
        const int row = row0 + ai * 128 + m * 16;
        const int t = row - b * TT;
        const bool isc = t >= TL;
        float* dst = isc ? xc + ((size_t)b * TC + (t - TL)) * DM : xout + ((size_t)b * TL + t) * DM;
        const float* src = src_input ? (isc ? cin + ((size_t)b * TC + (t - TL)) * DM : xin + ((size_t)b * TL + t) * DM) : dst;
        const float* gate = modl + (size_t)(isc ? 16 : b) * 6144 + gi * DM;
#pragma unroll
        for (int bj = 0; bj < 2; ++bj) {
          const int col = col0 + bj * 128;
#pragma unroll
          for (int n = 0; n < 2; ++n) {
            pg8::f32x4 sv = *(const pg8::f32x4*)(src + col + 4 * n);
            pg8::f32x4 gv = *(const pg8::f32x4*)(gate + col + 4 * n);
            pg8::f32x4 o = sv + gv * acc[ai][bj][m][n];
            *(pg8::f32x4*)(dst + col + 4 * n) = o;
          }
        }
      }
  }
};

struct EpiFfn {
  static constexpr bool PERM = true, AFTER_DRAIN = false;
  bfr* A2; float* EDGE; const float* cw; const float* cb; LAS float* bd;
  DI void operator()(const pg8::f32x4 (&acc)[2][2][4][2], const pg8::Unit& u, int wr, int wc, int fr, int fq) const {
    const int jl = wc * 32 + 8 * fq;
    const int j0 = u.pn * 128 + jl;
    const int m0 = u.pm * 256;
    const int t0 = m0 % TT;
#pragma unroll
    for (int ai = 0; ai < 2; ++ai) {
      const int sl = ai * 2 + wr;
      if (fr == 0) { *(LAS pg8::f32x4*)(bd + (sl * 2 + 0) * 128 + jl) = acc[ai][1][0][0]; *(LAS pg8::f32x4*)(bd + (sl * 2 + 0) * 128 + jl + 4) = acc[ai][1][0][1]; }
      if (fr == 15) { *(LAS pg8::f32x4*)(bd + (sl * 2 + 1) * 128 + jl) = acc[ai][1][3][0]; *(LAS pg8::f32x4*)(bd + (sl * 2 + 1) * 128 + jl + 4) = acc[ai][1][3][1]; }
    }
    asm volatile("s_waitcnt lgkmcnt(0)" ::: "memory");
    __builtin_amdgcn_s_barrier();
    asm volatile("" ::: "memory");
    constexpr bool ror1_is_prev = true;
    unsigned keep[2][4][2];
#pragma unroll
    for (int n = 0; n < 2; ++n) {
      const pg8::f32x4 c0 = *(const pg8::f32x4*)(cw + j0 + 4 * n), c1 = *(const pg8::f32x4*)(cw + DFF + j0 + 4 * n), c2 = *(const pg8::f32x4*)(cw + 2 * DFF + j0 + 4 * n), cbv = *(const pg8::f32x4*)(cb + j0 + 4 * n);
#pragma unroll
      for (int ai = 0; ai < 2; ++ai) {
        const int sl = ai * 2 + wr;
        const pg8::f32x4 bprev = (sl > 0) ? *(const LAS pg8::f32x4*)(bd + ((sl - 1) * 2 + 1) * 128 + jl + 4 * n) : (pg8::f32x4){0.f, 0.f, 0.f, 0.f};
        const pg8::f32x4 bnext = (sl < 3) ? *(const LAS pg8::f32x4*)(bd + ((sl + 1) * 2 + 0) * 128 + jl + 4 * n) : (pg8::f32x4){0.f, 0.f, 0.f, 0.f};
#pragma unroll
        for (int m = 0; m < 4; ++m) {
          const int rl = ai * 128 + wr * 64 + m * 16 + fr;
          const int t = t0 + rl;
          const bool first = (t == 0) || (t == TL);
          const bool last = (t == TL - 1) || (t == TT - 1);
          const bool etop = (rl == 0) && !first, ebot = (rl == 255) && !last;
          float ov[4];
#pragma unroll
          for (int e = 0; e < 4; ++e) {
            const float g = acc[ai][1][m][n][e], uv = acc[ai][0][m][n][e];
            const float xa = dppf<0x121>(g), xb = dppf<0x12F>(g);
            const float same_prev = ror1_is_prev ? xa : xb, same_next = ror1_is_prev ? xb : xa;
            float oprev, onext;
            if (m > 0) { const float pv = acc[ai][1][m > 0 ? m - 1 : 0][n][e]; const float pa = dppf<0x121>(pv), pb = dppf<0x12F>(pv); oprev = ror1_is_prev ? pa : pb; }
            else oprev = bprev[e];
            if (m < 3) { const float nv = acc[ai][1][m < 3 ? m + 1 : 3][n][e]; const float na = dppf<0x121>(nv), nb = dppf<0x12F>(nv); onext = ror1_is_prev ? nb : na; }
            else onext = bnext[e];
            const float gm = (fr == 0) ? oprev : same_prev;
            const float gp = (fr == 15) ? onext : same_next;
            if (etop) {
              float* ed = EDGE + ((size_t)(u.pm * 2 + 0) * DFF + j0 + 4 * n + e) * 3;
              ed[0] = c1[e] * g + c2[e] * gp + cbv[e]; ed[1] = uv; ed[2] = g;
            } else if (ebot) {
              float* ed = EDGE + ((size_t)(u.pm * 2 + 1) * DFF + j0 + 4 * n + e) * 3;
              ed[0] = c0[e] * gm + c1[e] * g + cbv[e]; ed[1] = uv; ed[2] = g;
            }
            const float z = c0[e] * gm + c1[e] * g + c2[e] * gp + cbv[e];
            ov[e] = z * __builtin_amdgcn_rcpf(1.f + __expf(-z)) * uv;
          }
          {
            const unsigned p0 = pg8::cvt_pk_bf16(ov[0], ov[1]), p1 = pg8::cvt_pk_bf16(ov[2], ov[3]);
            if (n == 0) { keep[ai][m][0] = p0; keep[ai][m][1] = p1; }
            else if (!etop && !ebot) {
              u32x4 w; w.x = keep[ai][m][0]; w.y = keep[ai][m][1]; w.z = p0; w.w = p1;
              *(u32x4*)(A2 + (size_t)(m0 + rl) * DFF + j0) = w;
            }
          }
        }
      }
    }
  }
};

struct EpiLora {
  static constexpr bool PERM = true, AFTER_DRAIN = false;
  bfr* RW; const float* w0; const float* a0;
  DI void operator()(const pg8::f32x4 (&acc)[2][2][4][2], const pg8::Unit& u, int wr, int wc, int fr, int fq) const {
    const int row0 = u.pm * 256 + wr * 64 + fr, cl = wc * 32 + 8 * fq;
    const int kind = u.pn;
    bfr* base = RW + (size_t)kind * MR * 256;
    const float osc = (kind < 2) ? 0.6065306597126334f : 1.f;
#pragma unroll
    for (int bj = 0; bj < 2; ++bj) {
      const int c0 = cl + bj * 128;
      float bias[8];
#pragma unroll
      for (int q = 0; q < 8; ++q) bias[q] = (kind < 2) ? w0[kind * 256 + c0 + q] : ((kind < 4) ? a0[(kind - 2) * 256 + c0 + q] : 0.f);
#pragma unroll
      for (int ai = 0; ai < 2; ++ai)
#pragma unroll
        for (int m = 0; m < 4; ++m) {
          float o[8];
#pragma unroll
          for (int n = 0; n < 2; ++n)
#pragma unroll
            for (int e = 0; e < 4; ++e) {
              const float x = acc[ai][bj][m][n][e] + bias[n * 4 + e];
              const float sg = osc * __builtin_amdgcn_rcpf(1.f + __expf(-x));
              o[n * 4 + e] = (kind < 4) ? sg : x;
            }
          u32x4 w; w.x = pg8::cvt_pk_bf16(o[0], o[1]); w.y = pg8::cvt_pk_bf16(o[2], o[3]); w.z = pg8::cvt_pk_bf16(o[4], o[5]); w.w = pg8::cvt_pk_bf16(o[6], o[7]);
          *(u32x4*)(base + (size_t)(row0 + ai * 128 + m * 16) * 256 + c0) = w;
        }
    }
  }
};

DN void phase_lora(const Params& p, int l) {
  pg8::Gemm g; g.A = (const bfr*)(p.ws + OFF_HO); g.Bt = (const bfr*)(p.ws + OFF_WLORA); g.M = MR; g.N = 1280; { int kk_ = 384; asm volatile("" : "+s"(kk_)); g.K = kk_; }
  MySched S; S.init(144, 5, gridDim.x, blockIdx.x, false); S.lora = true;
  { int nt_ = 2; asm volatile("" : "+s"(nt_)); g.ntov = nt_; }
  EpiLora E; E.RW = (bfr*)(p.ws + OFF_RWIN); E.w0 = p.in[oidx(11)] + (size_t)l * 512; E.a0 = p.in[oidx(13)] + (size_t)l * 512;
  pg8::gemm_phase<EpiLora, MySched, true, true>((LAS unsigned char*)dynlds, g, S, E);
}

DN void phase_g1(const Params& p) {
  pg8::Gemm g; g.A = (const bfr*)(p.ws + OFF_HO); g.Bt = (const bfr*)(p.ws + OFF_WIN); g.M = MR; g.N = NINP; g.K = DM;
  MySched S; S.init(144, 13, gridDim.x, blockIdx.x, false);
  EpiP E; E.P = (bfr*)(p.ws + OFF_P);
  pg8::gemm_phase<EpiP, MySched, true, true>((LAS unsigned char*)dynlds, g, S, E);
}

DN void phase_resid_gemm(const Params& p, int l, const bfr* A, const bfr* Bt, int K, int gi, bool src_input, bool skip_ctx) {
  pg8::Gemm g; g.A = A; g.Bt = Bt; g.M = MR; g.N = DM; g.K = K;
  MySched S; S.init(skip_ctx ? 128 : 144, 4, gridDim.x, blockIdx.x, skip_ctx);
  EpiResid E; E.xin = p.in[oidx(0)]; E.cin = p.in[oidx(2)]; E.xout = p.out; E.xc = (float*)(p.ws + OFF_XC);
  E.modl = (const float*)(p.ws + OFF_MOD) + (size_t)l * 17 * 6144; E.gi = gi; E.src_input = src_input;
  pg8::gemm_phase<EpiResid, MySched, true, true>((LAS unsigned char*)dynlds, g, S, E);
}

DN void phase_g3(const Params& p, int l, bool skip_ctx) {
  pg8::Gemm g; g.A = (const bfr*)(p.ws + OFF_HO); g.Bt = (const bfr*)(p.ws + OFF_WUP); g.M = MR; g.N = 2 * DFF; g.K = DM;
  MySched S; S.init(skip_ctx ? 128 : 144, 22, gridDim.x, blockIdx.x, skip_ctx);
  EpiFfn E; E.A2 = (bfr*)(p.ws + OFF_A2); E.EDGE = (float*)(p.ws + OFF_EDGE);
  E.cw = p.in[oidx(29)] + (size_t)l * 3 * DFF; E.cb = p.in[oidx(30)] + (size_t)l * DFF; E.bd = (LAS float*)(dynlds + LDS_BD_OFF);
  pg8::gemm_phase<EpiFfn, MySched, true, true>((LAS unsigned char*)dynlds, g, S, E);
}

DN void phase_fix(const Params& p, int l, bool skip_ctx) {
  bfr* A2 = (bfr*)(p.ws + OFF_A2);
  const float* EDGE = (const float*)(p.ws + OFF_EDGE);
  const float* cw = p.in[oidx(29)] + (size_t)l * 3 * DFF;
  const int gtid = VB() * 256 + otid(), gsz = NVB() * 256;
  const int total = 144 * 2 * DFF;
  for (int i = gtid; i < total; i += gsz) {
    int j = i % DFF, te = i / DFF;
    int tile = te >> 1, e = te & 1;
    int m0 = tile * 256;
    int t0 = m0 % TT;
    if (skip_ctx && t0 >= TL) continue;
    int rl = e ? 255 : 0;
    int t = t0 + rl;
    bool first = (t == 0) || (t == TL);
    bool last = (t == TL - 1) || (t == TT - 1);
    if (e == 0 && first) continue;
    if (e == 1 && last) continue;
    const float* me = EDGE + ((size_t)(tile * 2 + e) * DFF + j) * 3;
    const float* ot = e ? (EDGE + ((size_t)((tile + 1) * 2 + 0) * DFF + j) * 3) : (EDGE + ((size_t)((tile - 1) * 2 + 1) * DFF + j) * 3);
    float cwr = e ? cw[2 * DFF + j] : cw[j];
    float z = me[0] + cwr * ot[2];
    float a = z * __builtin_amdgcn_rcpf(1.f + __expf(-z)) * me[1];
    A2[(size_t)(m0 + rl) * DFF + j] = f2bf(a);
  }
}

DN void fix_own_tiles(const Params& p, int l, bool skip_ctx) {
  bfr* A2 = (bfr*)(p.ws + OFF_A2);
  const float* EDGE = (const float*)(p.ws + OFF_EDGE);
  const float* cw = p.in[oidx(29)] + (size_t)l * 3 * DFF;
  MySched S; S.init(skip_ctx ? 128 : 144, 4, gridDim.x, blockIdx.x, skip_ctx);
  int tid_ = threadIdx.x; asm volatile("" : "+v"(tid_));
  pg8::Unit u;
  for (int ui = 0; S.next(ui, u); ++ui) {
    const int tile = u.pm, m0 = tile * 256, t0 = m0 % TT;
    for (int i = tid_; i < 2 * DFF; i += 512) {
      const int e = (i >= DFF) ? 1 : 0, j = i - e * DFF;
      const int rl = e ? 255 : 0, t = t0 + rl;
      const bool first = (t == 0) || (t == TL), last = (t == TL - 1) || (t == TT - 1);
      if ((e == 0 && first) || (e == 1 && last)) continue;
      const float* me = EDGE + ((size_t)(tile * 2 + e) * DFF + j) * 3;
      const float* ot = e ? (EDGE + ((size_t)((tile + 1) * 2 + 0) * DFF + j) * 3) : (EDGE + ((size_t)((tile - 1) * 2 + 1) * DFF + j) * 3);
      const float cwr = e ? cw[2 * DFF + j] : cw[j];
      const float z = me[0] + cwr * ot[2];
      const float a = z * __builtin_amdgcn_rcpf(1.f + __expf(-z)) * me[1];
      A2[(size_t)(m0 + rl) * DFF + j] = f2bf(a);
    }
  }
  __syncthreads();
}

DI void unpack8(const u32x4 w, float (&o)[8]) {
  o[0] = __uint_as_float(w.x << 16); o[1] = __uint_as_float(w.x & 0xffff0000u);
  o[2] = __uint_as_float(w.y << 16); o[3] = __uint_as_float(w.y & 0xffff0000u);
  o[4] = __uint_as_float(w.z << 16); o[5] = __uint_as_float(w.z & 0xffff0000u);
  o[6] = __uint_as_float(w.w << 16); o[7] = __uint_as_float(w.w & 0xffff0000u);
}
DI void load8f(const float* p8, float (&o)[8]) {
  const f32x4v a = *(const f32x4v*)p8, b = *(const f32x4v*)(p8 + 4);
  o[0] = a.x; o[1] = a.y; o[2] = a.z; o[3] = a.w; o[4] = b.x; o[5] = b.y; o[6] = b.z; o[7] = b.w;
}
DI void shifted_load(const bfr* P, int m, int t, int col, const float* mu, float& out) {
  const bfr* row = P + (size_t)m * PW + col;
  float x = bf2f(row[0]);
  float xp = (t != 0 && t != TL) ? bf2f(row[-PW]) : 0.f;
  float xn = (t != TL - 1 && t != TT - 1) ? bf2f(row[PW]) : 0.f;
  out = x + mu[col] * (xp - x) + mu[1152 + col] * (xn - x);
}

DN void phase_prep(const Params& p, int l, char* smem) {
  bfr* P = (bfr*)(p.ws + OFF_P);
  bfr* AL = (bfr*)(p.ws + OFF_HO);
  const float* rope = (const float*)(p.ws + OFF_ROPE);
  const float* mu = p.in[oidx(10)] + (size_t)l * 2 * 1152;
  const int tid = otid(), lane = tid & 63, w = tid >> 6;
  for (int tile = VB(); tile < MR / 8; tile += NVB()) {
    int m0 = tile * 8;
    for (int i = tid; i < 8 * 48; i += 256) {
      const int tk = i / 48, g8 = i - tk * 48, cc = g8 * 8;
      const int m = m0 + tk, t = m % TT;
      const bfr* row = P + (size_t)m * PW + 768 + cc;
      const bool hp = (t != 0 && t != TL), hn = (t != TL - 1 && t != TT - 1);
      const u32x4 cur = *(const u32x4*)row;
      u32x4 prv = {0u, 0u, 0u, 0u}, nxt = {0u, 0u, 0u, 0u};
      if (hp) prv = *(const u32x4*)(row - PW);
      if (hn) nxt = *(const u32x4*)(row + PW);
      const f32x4v ma0 = *(const f32x4v*)(mu + 768 + cc), ma1 = *(const f32x4v*)(mu + 768 + cc + 4);
      const f32x4v mb0 = *(const f32x4v*)(mu + 1152 + 768 + cc), mb1 = *(const f32x4v*)(mu + 1152 + 768 + cc + 4);
      const float m0v[8] = {ma0.x, ma0.y, ma0.z, ma0.w, ma1.x, ma1.y, ma1.z, ma1.w};
      const float m1v[8] = {mb0.x, mb0.y, mb0.z, mb0.w, mb1.x, mb1.y, mb1.z, mb1.w};
      const unsigned cw_[4] = {cur.x, cur.y, cur.z, cur.w}, pw_[4] = {prv.x, prv.y, prv.z, prv.w}, nw_[4] = {nxt.x, nxt.y, nxt.z, nxt.w};
      float val[8];
#pragma unroll
      for (int e = 0; e < 8; ++e) {
        const float x = (e & 1) ? __uint_as_float(cw_[e >> 1] & 0xffff0000u) : __uint_as_float(cw_[e >> 1] << 16);
        const float xp = (e & 1) ? __uint_as_float(pw_[e >> 1] & 0xffff0000u) : __uint_as_float(pw_[e >> 1] << 16);
        const float xn = (e & 1) ? __uint_as_float(nw_[e >> 1] & 0xffff0000u) : __uint_as_float(nw_[e >> 1] << 16);
        const float xs = x + m0v[e] * (xp - x) + m1v[e] * (xn - x);
        val[e] = (cc < 128) ? (1.f - 2.f * __builtin_amdgcn_rcpf(1.f + __expf(2.f * xs))) : ((cc < 256) ? xs : __builtin_amdgcn_rcpf(1.f + __expf(-xs)));
      }
      u32x4 ow; ow.x = pack2(val[0], val[1]); ow.y = pack2(val[2], val[3]); ow.z = pack2(val[4], val[5]); ow.w = pack2(val[6], val[7]);
      *(u32x4*)(AL + (size_t)m * 384 + cc) = ow;
    }
    for (int i = tid; i < 8 * 112; i += 256) {
      const int tk = i / 112, gi = i - tk * 112;
      const int m = m0 + tk, t = m % TT;
      const bool da = gi < 64;
      const int gq = gi - 64;
      const bool isq = da ? (gi < 32) : (gq < 32);
      const int col = da ? (1152 + 8 * gi) : (isq ? (2720 + 8 * gq) : (2976 + 8 * (gq - 32)));
      const int dofs = da ? ((gi & 3) * 8) : ((gq & 7) * 8);
      bfr* ptr = P + (size_t)m * PW + col;
      float x[8], gs[8];
      unpack8(*(const u32x4*)ptr, x);
      load8f(da ? (p.in[oidx(21)] + (l * 2 + (isq ? 0 : 1)) * 32 + dofs) : (p.in[oidx(27)] + (l * 2 + (isq ? 0 : 1)) * 64 + dofs), gs);
      float ss = 0.f;
#pragma unroll
      for (int e = 0; e < 8; ++e) ss += x[e] * x[e];
      ss += dppf<0xB1>(ss); ss += dppf<0x4E>(ss);
      const float ss8 = ss + dppf<0x141>(ss);
      const float rstd = da ? rsqrtf(ss * (1.f / 32.f) + 1e-6f) : rsqrtf(ss8 * (1.f / 64.f) + 1e-6f);
      float y[8];
#pragma unroll
      for (int e = 0; e < 8; ++e) y[e] = x[e] * rstd * gs[e];
      float yp2[8], yp4[8];
#pragma unroll
      for (int e = 0; e < 8; ++e) { yp2[e] = __shfl_xor(y[e], 2); yp4[e] = __shfl_xor(y[e], 4); }
      if (t < TL) {
        const int idx0 = da ? ((gi & 1) * 8) : ((gq & 3) * 8);
        const bool first = da ? ((gi & 2) == 0) : ((gq & 4) == 0);
        float cs[8], sn[8];
        load8f(rope + t * 96 + (da ? 0 : 32) + idx0, cs);
        load8f(rope + t * 96 + (da ? 16 : 64) + idx0, sn);
#pragma unroll
        for (int e = 0; e < 8; ++e) {
          const float yp = da ? yp2[e] : yp4[e];
          y[e] = first ? (y[e] * cs[e] - yp * sn[e]) : (y[e] * cs[e] + yp * sn[e]);
        }
      }
      const float qs = isq ? (da ? 0.25503486f : 0.18033688f) : 1.f;
      u32x4 ow; ow.x = pack2(y[0] * qs, y[1] * qs); ow.y = pack2(y[2] * qs, y[3] * qs); ow.z = pack2(y[4] * qs, y[5] * qs); ow.w = pack2(y[6] * qs, y[7] * qs);
      *(u32x4*)ptr = ow;
    }
  }
}

template <int D>
DI void attn_pass(const bfr* __restrict__ P, int b, int tq_wave, int qcol, int kcol, int vcol, int key0, int nkt, char* smem, f32x16 (&o)[2]) {
  constexpr int KS = D / 16, KP = D + 8, NKR = D / 32, CPR = D / 8;
  bfr* sbase = (bfr*)dynlds;
  const int tid = otid(), lane = tid & 63, r = lane & 31, h = lane >> 5;
  const int gt = vhalf() * 256 + tid;
  bf16x8 qf[KS];
  {
    const bfr* qrow = P + (size_t)(b * TT + tq_wave + r) * PW + qcol;
#pragma unroll
    for (int ks = 0; ks < KS; ++ks) qf[ks] = *(const bf16x8*)(qrow + ks * 16 + h * 8);
  }
  f32x16 accO[2];
#pragma unroll
  for (int i = 0; i < 16; ++i) { accO[0][i] = 0.f; accO[1][i] = 0.f; }
  float mrun = -1e30f, lsum = 0.f;
  u32x4 kreg[1], vreg[1];
  const bfr* Pb = P + (size_t)(b * TT + key0) * PW;
  static_assert(D == 64, "block-mode attention pass stages one 16-byte K chunk per thread");
  { int c = gt, row = c >> 3, kc = c & 7; kreg[0] = *(const u32x4*)(Pb + (size_t)row * PW + kcol + kc * 8); vreg[0] = *(const u32x4*)(Pb + (size_t)row * PW + vcol + kc * 8); }
  for (int kt = 0; kt < nkt; ++kt) {
    bfr* sK = sbase + (kt & 1) * 9216;
    bfr* sV = sK + 64 * 72;
    { int c = gt, row = c >> 3, kc = c & 7; *(u32x4*)(sK + row * KP + kc * 8) = kreg[0]; }
    for (int i = 0; i < 1; ++i) {
      int c = gt, row = c >> 3, kc = c & 7;
      unsigned wds[4] = {vreg[i].x, vreg[i].y, vreg[i].z, vreg[i].w};
#pragma unroll
      for (int e = 0; e < 4; ++e) {
        sV[(kc * 8 + 2 * e) * 72 + (row ^ (kc << 3))] = (bfr)(wds[e] & 0xffffu);
        sV[(kc * 8 + 2 * e + 1) * 72 + (row ^ (kc << 3))] = (bfr)(wds[e] >> 16);
      }
    }
    __syncthreads();
    if (kt + 1 < nkt) {
      const bfr* Pn = Pb + (size_t)(kt + 1) * 64 * PW;
      { int c = gt, row = c >> 3, kc = c & 7; kreg[0] = *(const u32x4*)(Pn + (size_t)row * PW + kcol + kc * 8); vreg[0] = *(const u32x4*)(Pn + (size_t)row * PW + vcol + kc * 8); }
    }
    f32x16 s[2];
#pragma unroll
    for (int t2 = 0; t2 < 2; ++t2) {
#pragma unroll
      for (int i = 0; i < 16; ++i) s[t2][i] = 0.f;
#pragma unroll
      for (int ks = 0; ks < KS; ++ks) {
        bf16x8 a = *(const bf16x8*)(sK + (t2 * 32 + r) * KP + ks * 16 + h * 8);
        s[t2] = MFMA32(a, qf[ks], s[t2]);
      }
    }
    float mx = s[0][0];
#pragma unroll
    for (int i = 0; i < 16; ++i) { mx = fmaxf(mx, s[0][i]); mx = fmaxf(mx, s[1][i]); }
    mx = fmaxf(mx, __shfl_xor(mx, 32));
    float mnew = fmaxf(mrun, mx);
    float alpha = __builtin_amdgcn_exp2f(mrun - mnew);
    mrun = mnew;
    float ps = 0.f;
#pragma unroll
    for (int i = 0; i < 16; ++i) {
      s[0][i] = __builtin_amdgcn_exp2f(s[0][i] - mnew); ps += s[0][i];
      s[1][i] = __builtin_amdgcn_exp2f(s[1][i] - mnew); ps += s[1][i];
    }
    lsum = lsum * alpha + ps;
#pragma unroll
    for (int i = 0; i < 16; ++i) { accO[0][i] *= alpha; accO[1][i] *= alpha; }
#pragma unroll
    for (int t2 = 0; t2 < 2; ++t2)
#pragma unroll
      for (int j = 0; j < 2; ++j) {
        unsigned pk[4];
#pragma unroll
        for (int e = 0; e < 4; ++e) pk[e] = pack2(s[t2][8 * j + 2 * e], s[t2][8 * j + 2 * e + 1]);
        u32x4 pku = {pk[0], pk[1], pk[2], pk[3]};
        bf16x8 pf = __builtin_bit_cast(bf16x8, pku);
#pragma unroll
        for (int dt = 0; dt < 2; ++dt) {
          const int vsw = (((dt * 32 + r) >> 3) & 7) << 3;
          const bfr* vrow = sV + (dt * 32 + r) * 72;
          s16x4 lo = *(const s16x4*)(vrow + ((t2 * 32 + 16 * j + 4 * h) ^ vsw));
          s16x4 hi = *(const s16x4*)(vrow + ((t2 * 32 + 16 * j + 4 * h + 8) ^ vsw));
          bf16x8 vf = __builtin_shufflevector(lo, hi, 0, 1, 2, 3, 4, 5, 6, 7);
          accO[dt] = MFMA32(vf, pf, accO[dt]);
        }
      }
  }
  lsum += __shfl_xor(lsum, 32);
  float inv = 1.f / lsum;
#pragma unroll
  for (int i = 0; i < 16; ++i) { o[0][i] = accO[0][i] * inv; o[1][i] = accO[1][i] * inv; }
}

DI void attn_pass_da(const bfr* __restrict__ P, int b, int tq_wave, int qcol, int kcol, int vcol, int key0, int nkt, char* smem, f32x16 (&o0)[2], f32x16 (&o1)[2]) {
  constexpr int KP = 72;
  bfr* sbase = (bfr*)dynlds;
  const int tid = otid(), lane = tid & 63, r = lane & 31, h = lane >> 5;
  const int gt = vhalf() * 256 + tid;
  bf16x8 qf[4];
  {
    const bfr* qrow = P + (size_t)(b * TT + tq_wave + r) * PW + qcol;
#pragma unroll
    for (int ks = 0; ks < 4; ++ks) qf[ks] = *(const bf16x8*)(qrow + ks * 16 + h * 8);
  }
  f32x16 acc0[2], acc1[2];
#pragma unroll
  for (int i = 0; i < 16; ++i) { acc0[0][i] = 0.f; acc0[1][i] = 0.f; acc1[0][i] = 0.f; acc1[1][i] = 0.f; }
  float m0 = -1e30f, l0 = 0.f, m1 = -1e30f, l1 = 0.f;
  u32x4 kreg[1], vreg[1];
  const bfr* Pb = P + (size_t)(b * TT + key0) * PW;
  { int c = gt, row = c >> 3, kc = c & 7; kreg[0] = *(const u32x4*)(Pb + (size_t)row * PW + kcol + kc * 8); vreg[0] = *(const u32x4*)(Pb + (size_t)row * PW + vcol + kc * 8); }
  for (int kt = 0; kt < nkt; ++kt) {
    bfr* sK = sbase + (kt & 1) * 9216;
    bfr* sV = sK + 64 * 72;
    { int c = gt, row = c >> 3, kc = c & 7; *(u32x4*)(sK + row * KP + kc * 8) = kreg[0]; }
    for (int i = 0; i < 1; ++i) {
      int c = gt, row = c >> 3, kc = c & 7;
      unsigned wds[4] = {vreg[i].x, vreg[i].y, vreg[i].z, vreg[i].w};
#pragma unroll
      for (int e = 0; e < 4; ++e) {
        sV[(kc * 8 + 2 * e) * 72 + (row ^ (kc << 3))] = (bfr)(wds[e] & 0xffffu);
        sV[(kc * 8 + 2 * e + 1) * 72 + (row ^ (kc << 3))] = (bfr)(wds[e] >> 16);
      }
    }
    __syncthreads();
    if (kt + 1 < nkt) {
      const bfr* Pn = Pb + (size_t)(kt + 1) * 64 * PW;
      { int c = gt, row = c >> 3, kc = c & 7; kreg[0] = *(const u32x4*)(Pn + (size_t)row * PW + kcol + kc * 8); vreg[0] = *(const u32x4*)(Pn + (size_t)row * PW + vcol + kc * 8); }
    }
    f32x16 s0[2], s1[2];
#pragma unroll
    for (int t2 = 0; t2 < 2; ++t2) {
#pragma unroll
      for (int i = 0; i < 16; ++i) { s0[t2][i] = 0.f; s1[t2][i] = 0.f; }
#pragma unroll
      for (int ks = 0; ks < 2; ++ks) {
        bf16x8 a0 = *(const bf16x8*)(sK + (t2 * 32 + r) * KP + ks * 16 + h * 8);
        bf16x8 a1 = *(const bf16x8*)(sK + (t2 * 32 + r) * KP + 32 + ks * 16 + h * 8);
        s0[t2] = MFMA32(a0, qf[ks], s0[t2]);
        s1[t2] = MFMA32(a1, qf[2 + ks], s1[t2]);
      }
    }
    float mx0 = s0[0][0], mx1 = s1[0][0];
#pragma unroll
    for (int i = 0; i < 16; ++i) { mx0 = fmaxf(mx0, fmaxf(s0[0][i], s0[1][i])); mx1 = fmaxf(mx1, fmaxf(s1[0][i], s1[1][i])); }
    mx0 = fmaxf(mx0, __shfl_xor(mx0, 32)); mx1 = fmaxf(mx1, __shfl_xor(mx1, 32));
    const float mn0 = fmaxf(m0, mx0), mn1 = fmaxf(m1, mx1);
    const float al0 = __builtin_amdgcn_exp2f(m0 - mn0), al1 = __builtin_amdgcn_exp2f(m1 - mn1);
    m0 = mn0; m1 = mn1;
    float ps0 = 0.f, ps1 = 0.f;
#pragma unroll
    for (int i = 0; i < 16; ++i) {
      s0[0][i] = __builtin_amdgcn_exp2f(s0[0][i] - mn0); ps0 += s0[0][i];
      s0[1][i] = __builtin_amdgcn_exp2f(s0[1][i] - mn0); ps0 += s0[1][i];
      s1[0][i] = __builtin_amdgcn_exp2f(s1[0][i] - mn1); ps1 += s1[0][i];
      s1[1][i] = __builtin_amdgcn_exp2f(s1[1][i] - mn1); ps1 += s1[1][i];
    }
    l0 = l0 * al0 + ps0; l1 = l1 * al1 + ps1;
#pragma unroll
    for (int i = 0; i < 16; ++i) { acc0[0][i] *= al0; acc0[1][i] *= al0; acc1[0][i] *= al1; acc1[1][i] *= al1; }
#pragma unroll
    for (int t2 = 0; t2 < 2; ++t2)
#pragma unroll
      for (int j = 0; j < 2; ++j) {
        u32x4 pk0, pk1;
        pk0.x = pack2(s0[t2][8 * j + 0], s0[t2][8 * j + 1]); pk0.y = pack2(s0[t2][8 * j + 2], s0[t2][8 * j + 3]);
        pk0.z = pack2(s0[t2][8 * j + 4], s0[t2][8 * j + 5]); pk0.w = pack2(s0[t2][8 * j + 6], s0[t2][8 * j + 7]);
        pk1.x = pack2(s1[t2][8 * j + 0], s1[t2][8 * j + 1]); pk1.y = pack2(s1[t2][8 * j + 2], s1[t2][8 * j + 3]);
        pk1.z = pack2(s1[t2][8 * j + 4], s1[t2][8 * j + 5]); pk1.w = pack2(s1[t2][8 * j + 6], s1[t2][8 * j + 7]);
        const bf16x8 pf0 = __builtin_bit_cast(bf16x8, pk0), pf1 = __builtin_bit_cast(bf16x8, pk1);
#pragma unroll
        for (int dt = 0; dt < 2; ++dt) {
          const int vsw = (((dt * 32 + r) >> 3) & 7) << 3;
          const bfr* vrow = sV + (dt * 32 + r) * 72;
          s16x4 lo = *(const s16x4*)(vrow + ((t2 * 32 + 16 * j + 4 * h) ^ vsw));
          s16x4 hi = *(const s16x4*)(vrow + ((t2 * 32 + 16 * j + 4 * h + 8) ^ vsw));
          bf16x8 vf = __builtin_shufflevector(lo, hi, 0, 1, 2, 3, 4, 5, 6, 7);
          acc0[dt] = MFMA32(vf, pf0, acc0[dt]);
          acc1[dt] = MFMA32(vf, pf1, acc1[dt]);
        }
      }
  }
  l0 += __shfl_xor(l0, 32); l1 += __shfl_xor(l1, 32);
  const float i0 = 1.f / l0, i1 = 1.f / l1;
#pragma unroll
  for (int i = 0; i < 16; ++i) { o0[0][i] = acc0[0][i] * i0; o0[1][i] = acc0[1][i] * i0; o1[0][i] = acc1[0][i] * i1; o1[1][i] = acc1[1][i] * i1; }
}

DI void store_o(bfr* O, int m, int colbase, int h, const f32x16 (&o)[2]) {
#pragma unroll
  for (int dt = 0; dt < 2; ++dt)
#pragma unroll
    for (int g4 = 0; g4 < 4; ++g4) {
      int dv = dt * 32 + 8 * g4 + 4 * h;
      uint2 pk; pk.x = pack2(o[dt][4 * g4], o[dt][4 * g4 + 1]); pk.y = pack2(o[dt][4 * g4 + 2], o[dt][4 * g4 + 3]);
      *(uint2*)(O + (size_t)m * DM + colbase + dv) = pk;
    }
}

DN void da_item(const Params& p, int l, int b, int hd, int tq0, int key0, int nkt, char* smem) {
  const bfr* P = (const bfr*)(p.ws + OFF_P);
  bfr* O = (bfr*)(p.ws + OFF_HO);
  const int tid = otid(), lane = tid & 63, w = tid >> 6, r = lane & 31, h = lane >> 5;
  const float* lv = p.in[oidx(22)] + l * 128;
  float d01 = (lane < 32) ? lv[lane] * lv[32 + lane] : 0.f;
  float d23 = (lane < 32) ? lv[64 + lane] * lv[96 + lane] : 0.f;
  d01 = wave_sum(d01); d23 = wave_sum(d23);
  float lam_init = 0.8f - 0.6f * expf(-0.3f * (float)l);
  float lam = expf(d01) - expf(d23) + lam_init;
  f32x16 o0[2], o1[2];
  int tqw = tq0 + vhalf() * 128 + w * 32;
  attn_pass_da(P, b, tqw, 1152 + hd * 64, 1408 + hd * 64, 1664 + hd * 64, key0, nkt, smem, o0, o1);
  float ss = 0.f;
#pragma unroll
  for (int dt = 0; dt < 2; ++dt)
#pragma unroll
    for (int i = 0; i < 16; ++i) { float v = o0[dt][i] - lam * o1[dt][i]; o0[dt][i] = v; ss += v * v; }
  ss += __shfl_xor(ss, 32);
  float rstd = rsqrtf(ss * (1.f / 64.f) + 1e-6f) * (1.f - lam_init);
  const float* sg = p.in[oidx(23)] + l * 64;
#pragma unroll
  for (int dt = 0; dt < 2; ++dt)
#pragma unroll
    for (int i = 0; i < 16; ++i) { int dv = dt * 32 + 8 * (i >> 2) + 4 * h + (i & 3); o0[dt][i] = o0[dt][i] * rstd * sg[dv]; }
  store_o(O, b * TT + tqw + r, 256 + hd * 64, h, o0);
}

DN void gqa_item(const Params& p, int b, int hq, int tq0, int key0, int nkt, char* smem) {
  const bfr* P = (const bfr*)(p.ws + OFF_P);
  bfr* O = (bfr*)(p.ws + OFF_HO);
  const int tid = otid(), lane = tid & 63, w = tid >> 6, r = lane & 31, h = lane >> 5;
  f32x16 o[2];
  int tqw = tq0 + vhalf() * 128 + w * 32;
  attn_pass<64>(P, b, tqw, 2720 + hq * 64, 2976 + (hq >> 1) * 64, 3104 + (hq >> 1) * 64, key0, nkt, smem, o);
  store_o(O, b * TT + tqw + r, 768 + hq * 64, h, o);
}

struct RwRegs { bfr lr[4][3], lk[4][3], lv[4][3], le[4], la[4]; };

DN void rw_scan_item(const Params& p, int l, int item, bool need_ctx, int mode) {
  const int dir = item & 1, hh = (item >> 1) & 3, b = item >> 3;
  const int half = vhalf();
  float* lbase = (float*)dynlds;
  const bfr* P = (const bfr*)(p.ws + OFF_P);
  const bfr* RWE = (const bfr*)(p.ws + OFF_RWIN) + (size_t)dir * MR * 256;
  const bfr* RWA = (const bfr*)(p.ws + OFF_RWIN) + (size_t)(2 + dir) * MR * 256;
  bfr* Y = (bfr*)(p.ws + OFF_RWY) + (size_t)dir * MR * 256;
  const int tid = otid();
  const int nchunks = TT / 16;
  auto tokof = [&](int tau) -> int {
    if (dir == 0) return (tau < TC) ? (TL + tau) : (tau - TC);
    return (tau < TC) ? (TL + TC - 1 - tau) : (TL - 1 - (tau - TC));
  };
  __syncthreads();
  if (half == 1) {
    const int ch = tid & 63, c256 = hh * 64 + ch;
    const float* mu = p.in[oidx(10)] + (size_t)l * 2 * 1152;
    const float mr0 = mu[c256], mr1 = mu[1152 + c256], mk0 = mu[256 + c256], mk1 = mu[1152 + 256 + c256], mv0 = mu[512 + c256], mv1 = mu[1152 + 512 + c256];
    const float kkw = p.in[oidx(16)][l * 256 + c256], kaw = p.in[oidx(17)][l * 256 + c256];
    auto gload = [&](RwRegs& R, int c) {
#pragma unroll
      for (int i = 0; i < 4; ++i) {
        int s = (tid >> 6) + 4 * i;
        int t = tokof(c * 16 + s);
        size_t m = (size_t)b * TT + t;
        bool hp = (t != 0 && t != TL), hn = (t != TL - 1 && t != TT - 1);
        const bfr* row = P + m * PW + c256;
        R.lr[i][1] = row[0]; R.lk[i][1] = row[256]; R.lv[i][1] = row[512];
        R.lr[i][0] = hp ? row[-PW] : (bfr)0; R.lk[i][0] = hp ? row[256 - PW] : (bfr)0; R.lv[i][0] = hp ? row[512 - PW] : (bfr)0;
        R.lr[i][2] = hn ? row[PW] : (bfr)0; R.lk[i][2] = hn ? row[256 + PW] : (bfr)0; R.lv[i][2] = hn ? row[512 + PW] : (bfr)0;
        R.le[i] = RWE[m * 256 + c256]; R.la[i] = RWA[m * 256 + c256];
      }
    };
    auto prep = [&](const RwRegs& R, int c) {
      float* vec = lbase + (c & 1) * 7168;
      float* vvv = vec + 16 * 5 * 64;
#pragma unroll
      for (int i = 0; i < 4; ++i) {
        int s = (tid >> 6) + 4 * i;
        float r0 = bf2f(R.lr[i][1]), k0 = bf2f(R.lk[i][1]), v0 = bf2f(R.lv[i][1]);
        float rr = r0 + mr0 * (bf2f(R.lr[i][0]) - r0) + mr1 * (bf2f(R.lr[i][2]) - r0);
        float kx = k0 + mk0 * (bf2f(R.lk[i][0]) - k0) + mk1 * (bf2f(R.lk[i][2]) - k0);
        float vx = v0 + mv0 * (bf2f(R.lv[i][0]) - v0) + mv1 * (bf2f(R.lv[i][2]) - v0);
        float kkp = kx * kkw;
        float ss = wave_sum(kkp * kkp);
        float kk = kkp * rsqrtf(ss + 1e-12f);
        float a = bf2f(R.la[i]);
        float wdec = __expf(-bf2f(R.le[i]));
        float kd = kx * (1.f + (a - 1.f) * kaw);
        float* vs = vec + s * 320;
        vs[ch] = wdec; vs[64 + ch] = kd; vs[128 + ch] = -kk; vs[192 + ch] = kk * a; vs[256 + ch] = rr;
        vvv[s * 64 + ch] = vx;
      }
    };
    auto yout = [&](int cprev) {
      const float* yb = lbase + (cprev & 1) * 7168 + 16 * 5 * 64 + 16 * 64;
#pragma unroll
      for (int i = 0; i < 4; ++i) {
        int idx = tid + 256 * i;
        int s = idx >> 6, rr = idx & 63;
        int t = tokof(cprev * 16 + s);
        if (t < TL || need_ctx) Y[((size_t)b * TT + t) * 256 + hh * 64 + rr] = f2bf(yb[s * 64 + rr]);
      }
    };
    RwRegs RA, RB;
    gload(RA, 0);
    gload(RB, 1);
    prep(RA, 0);
    if (mode != 2) gload(RA, 2);
    __syncthreads();
#pragma unroll 1
    for (int c = 0; c < nchunks; c += 2) {
      prep(RB, c + 1);
      if (c + 3 < nchunks && mode != 2) gload(RB, c + 3);
      if (c > 0 && mode == 0) yout(c - 1);
      __syncthreads();
      if (c + 2 < nchunks) prep(RA, c + 2);
      if (c + 4 < nchunks && mode != 2) gload(RA, c + 4);
      if (mode == 0) yout(c);
      __syncthreads();
    }
    if (mode == 0) yout(nchunks - 1);
  } else {
    const int rq = tid >> 4, j16 = tid & 15;
    f32x2 S[4][2];
#pragma unroll
    for (int k = 0; k < 4; ++k) { S[k][0] = (f32x2){0.f, 0.f}; S[k][1] = (f32x2){0.f, 0.f}; }
    __syncthreads();
#pragma unroll 1
    for (int c = 0; c < nchunks; ++c) {
      const float* vec = lbase + (c & 1) * 7168;
      const float* vvv = vec + 16 * 5 * 64;
      float* ybuf = lbase + (c & 1) * 7168 + 16 * 5 * 64 + 16 * 64;
      if (mode != 1) {
        float ykeep[4] = {0.f, 0.f, 0.f, 0.f};
#pragma unroll
        for (int hb = 0; hb < 2; ++hb) {
          float yp[4][8];
#pragma unroll
          for (int s8 = 0; s8 < 8; ++s8) {
            const int s = hb * 8 + s8;
            const float* vs = vec + s * 320 + j16 * 4;
            const f32x4v w0 = *(const f32x4v*)(vs);
            const f32x4v d0 = *(const f32x4v*)(vs + 64);
            const f32x4v a0 = *(const f32x4v*)(vs + 128);
            const f32x4v b0 = *(const f32x4v*)(vs + 192);
            const f32x4v q0 = *(const f32x4v*)(vs + 256);
            float sa[4], vi[4];
#pragma unroll
            for (int k = 0; k < 4; ++k) {
              vi[k] = vvv[s * 64 + rq + 16 * k];
              f32x2 t = S[k][0] * a0.xy;
              t = S[k][1] * a0.zw + t;
              sa[k] = t.x + t.y;
            }
#pragma unroll
            for (int k = 0; k < 4; ++k) sa[k] += dppf<0xB1>(sa[k]);
#pragma unroll
            for (int k = 0; k < 4; ++k) sa[k] += dppf<0x4E>(sa[k]);
#pragma unroll
            for (int k = 0; k < 4; ++k) sa[k] += dppf<0x141>(sa[k]);
#pragma unroll
            for (int k = 0; k < 4; ++k) sa[k] += dppf<0x140>(sa[k]);
#pragma unroll
            for (int k = 0; k < 4; ++k) {
              const f32x2 s2 = (f32x2){sa[k], sa[k]}, v2 = (f32x2){vi[k], vi[k]};
              S[k][0] = S[k][0] * w0.xy + (s2 * b0.xy + v2 * d0.xy);
              S[k][1] = S[k][1] * w0.zw + (s2 * b0.zw + v2 * d0.zw);
              f32x2 y2 = S[k][0] * q0.xy;
              y2 = S[k][1] * q0.zw + y2;
              yp[k][s8] = y2.x + y2.y;
            }
          }
#pragma unroll
          for (int s8 = 0; s8 < 8; ++s8)
#pragma unroll
            for (int k = 0; k < 4; ++k) {
              float ra = yp[k][s8];
              ra += dppf<0xB1>(ra); ra += dppf<0x4E>(ra); ra += dppf<0x141>(ra); ra += dppf<0x140>(ra);
              ykeep[k] = ((hb * 8 + s8) == j16) ? ra : ykeep[k];
            }
        }
#pragma unroll
        for (int k = 0; k < 4; ++k) ybuf[j16 * 64 + rq + 16 * k] = ykeep[k];
      }
      __syncthreads();
    }
  }
  __syncthreads();
}

DI float logsigf_(float x) { return fminf(x, 0.f) - __logf(1.f + __expf(-fabsf(x))); }

DN void gla_state_item(const Params& p, int l, int item, char* smem) {
  const int dir = item & 1, hh = (item >> 1) & 3, b = item >> 3;
  float* kk_ = (float*)smem;
  float* vv = kk_ + 64 * 33;
  float* bb = vv + 64 * 64;
  float* gg = bb + 64 * 33;
  float* sbend = gg + 64 * 16;
  float* segs = sbend + 32;
  const bfr* P = (const bfr*)(p.ws + OFF_P);
  float* GS = (float*)(p.ws + OFF_GS);
  const int tid = otid();
  const int d = tid >> 3, e0 = (tid & 7) * 8;
  float S[8];
#pragma unroll
  for (int e = 0; e < 8; ++e) S[e] = 0.f;
  const int dl = tid & 31, lgrp = tid >> 5;
  float a2c[16];
#pragma unroll
  for (int q = 0; q < 16; ++q) a2c[q] = p.in[oidx(24)][((size_t)(l * 2 + dir) * 16 + q) * 128 + hh * 32 + dl];
  const float abv = p.in[oidx(25)][(l * 2 + dir) * 128 + hh * 32 + dl];
  for (int c = 0; c < 36; ++c) {
    int cs = (dir == 0) ? (c < 4 ? 32 + c : c - 4) : (c < 4 ? 35 - c : 35 - c);
    size_t m0 = (size_t)b * TT + cs * 64;
    vsync();
    {
      float t8[8];
      { const int li = tid >> 2, d8 = (tid & 3) * 8; unpack8(*(const u32x4*)(P + (m0 + li) * PW + 2048 + hh * 32 + d8), t8);
#pragma unroll
        for (int e = 0; e < 8; ++e) kk_[li * 33 + d8 + e] = t8[e]; }
#pragma unroll
      for (int i = 0; i < 2; ++i) { const int c = tid + 256 * i, li = c >> 3, e8 = (c & 7) * 8; unpack8(*(const u32x4*)(P + (m0 + li) * PW + 2176 + hh * 64 + e8), t8);
        *(f32x4v*)(vv + li * 64 + e8) = (f32x4v){t8[0], t8[1], t8[2], t8[3]}; *(f32x4v*)(vv + li * 64 + e8 + 4) = (f32x4v){t8[4], t8[5], t8[6], t8[7]}; }
      if (tid < 128) { const int li = tid >> 1, q8 = (tid & 1) * 8; unpack8(*(const u32x4*)(P + (m0 + li) * PW + 2432 + dir * 16 + q8), t8);
        *(f32x4v*)(gg + li * 16 + q8) = (f32x4v){t8[0], t8[1], t8[2], t8[3]}; *(f32x4v*)(gg + li * 16 + q8 + 4) = (f32x4v){t8[4], t8[5], t8[6], t8[7]}; }
    }
    vsync();
    {
      float lgv[8];
#pragma unroll
      for (int li = 0; li < 8; ++li) {
        int lt = lgrp * 8 + li;
        float x = abv;
#pragma unroll
        for (int q = 0; q < 16; ++q) x += gg[lt * 16 + q] * a2c[q];
        lgv[li] = logsigf_(x) * (1.f / 16.f);
      }
      if (dir == 0) {
#pragma unroll
        for (int li = 1; li < 8; ++li) lgv[li] += lgv[li - 1];
        segs[lgrp * 32 + dl] = lgv[7];
      } else {
#pragma unroll
        for (int li = 6; li >= 0; --li) lgv[li] += lgv[li + 1];
        segs[lgrp * 32 + dl] = lgv[0];
      }
      vsync_l();
      float off = 0.f, tot = 0.f;
#pragma unroll
      for (int sg = 0; sg < 8; ++sg) {
        const float sv = segs[sg * 32 + dl];
        tot += sv;
        if ((dir == 0) ? (sg < lgrp) : (sg > lgrp)) off += sv;
      }
#pragma unroll
      for (int li = 0; li < 8; ++li) bb[(lgrp * 8 + li) * 33 + dl] = lgv[li] + off;
      if (lgrp == 0) sbend[dl] = tot;
    }
    vsync_l();
    for (int i = tid; i < 2048; i += 256) { int li = i >> 5, dd = i & 31; kk_[li * 33 + dd] *= __expf(sbend[dd] - bb[li * 33 + dd]); }
    {
      float* dst = GS + ((((size_t)b * 36 + cs) * 4 + hh) * 2 + dir) * 2048 + d * 64 + e0;
      *(float4*)dst = make_float4(S[0], S[1], S[2], S[3]);
      *(float4*)(dst + 4) = make_float4(S[4], S[5], S[6], S[7]);
    }
    vsync();
    float dec = __expf(sbend[d]);
#pragma unroll
    for (int e = 0; e < 8; ++e) S[e] *= dec;
    for (int lt = 0; lt < 64; ++lt) {
      float kv = kk_[lt * 33 + d];
      float4 v0 = *(const float4*)(vv + lt * 64 + e0), v1 = *(const float4*)(vv + lt * 64 + e0 + 4);
      S[0] += kv * v0.x; S[1] += kv * v0.y; S[2] += kv * v0.z; S[3] += kv * v0.w;
      S[4] += kv * v1.x; S[5] += kv * v1.y; S[6] += kv * v1.z; S[7] += kv * v1.w;
    }
  }
}

DN void gla_finish_item(const Params& p, int l, int b, int cs, int hh, char* smem) {
  bfr* QiB = (bfr*)smem;
  bfr* KiB = QiB + 64 * 40;
  bfr* StB = KiB + 64 * 40;
  bfr* VtB = StB + 64 * 40;
  float* bb = (float*)(VtB + 64 * 72);
  float* gg = bb + 64 * 33;
  float* segs = gg + 64 * 16;
  float* ssq = segs + 256;
  const bfr* P = (const bfr*)(p.ws + OFF_P);
  const float* GS = (const float*)(p.ws + OFF_GS);
  bfr* O = (bfr*)(p.ws + OFF_HO);
  const int tid = otid(), lane = tid & 63, w = tid >> 6, r = lane & 31, h = lane >> 5;
  const int et = w >> 1, it = w & 1;
  const size_t m0 = (size_t)b * TT + cs * 64;
  const int dl = tid & 31, lgrp = tid >> 5;
  const int li4 = tid >> 2, d8 = (tid & 3) * 8;
  f32x16 accO;
#pragma unroll
  for (int i = 0; i < 16; ++i) accO[i] = 0.f;
  vsync();
  {
#pragma unroll
    for (int i = 0; i < 2; ++i) {
      const int c = tid + 256 * i, row = c >> 3, kc = c & 7;
      const u32x4 v = *(const u32x4*)(P + (m0 + row) * PW + 2176 + hh * 64 + kc * 8);
      const unsigned wds[4] = {v.x, v.y, v.z, v.w};
#pragma unroll
      for (int e = 0; e < 4; ++e) {
        VtB[(kc * 8 + 2 * e) * 72 + (row ^ (kc << 3))] = (bfr)(wds[e] & 0xffffu);
        VtB[(kc * 8 + 2 * e + 1) * 72 + (row ^ (kc << 3))] = (bfr)(wds[e] >> 16);
      }
    }
  }
#pragma unroll 1
  for (int dir = 0; dir < 2; ++dir) {
    vsync_l();
    float q8[8], k8[8];
    unpack8(*(const u32x4*)(P + (m0 + li4) * PW + 1920 + hh * 32 + d8), q8);
    unpack8(*(const u32x4*)(P + (m0 + li4) * PW + 2048 + hh * 32 + d8), k8);
    if (tid < 128) {
      float t8[8];
      const int lg_ = tid >> 1, qq = (tid & 1) * 8;
      unpack8(*(const u32x4*)(P + (m0 + lg_) * PW + 2432 + dir * 16 + qq), t8);
      *(f32x4v*)(gg + lg_ * 16 + qq) = (f32x4v){t8[0], t8[1], t8[2], t8[3]}; *(f32x4v*)(gg + lg_ * 16 + qq + 4) = (f32x4v){t8[4], t8[5], t8[6], t8[7]};
    }
    {
      const float* Sg = GS + ((((size_t)b * 36 + cs) * 4 + hh) * 2 + dir) * 2048;
      const int d = tid >> 3, e8 = (tid & 7) * 8;
      float s8[8];
      load8f(Sg + d * 64 + e8, s8);
#pragma unroll
      for (int e = 0; e < 8; ++e) StB[(e8 + e) * 40 + d] = f2bf(s8[e]);
    }
    vsync_l();
    {
      float a2c[16];
#pragma unroll
      for (int q = 0; q < 16; ++q) a2c[q] = p.in[oidx(24)][((size_t)(l * 2 + dir) * 16 + q) * 128 + hh * 32 + dl];
      const float abv = p.in[oidx(25)][(l * 2 + dir) * 128 + hh * 32 + dl];
      float lgv[8];
#pragma unroll
      for (int li = 0; li < 8; ++li) {
        int lt = lgrp * 8 + li;
        float x = abv;
#pragma unroll
        for (int q = 0; q < 16; ++q) x += gg[lt * 16 + q] * a2c[q];
        lgv[li] = logsigf_(x) * (1.f / 16.f);
      }
      if (dir == 0) {
#pragma unroll
        for (int li = 1; li < 8; ++li) lgv[li] += lgv[li - 1];
        segs[lgrp * 32 + dl] = lgv[7];
      } else {
#pragma unroll
        for (int li = 6; li >= 0; --li) lgv[li] += lgv[li + 1];
        segs[lgrp * 32 + dl] = lgv[0];
      }
      vsync_l();
      float off = 0.f;
#pragma unroll
      for (int sg = 0; sg < 8; ++sg) {
        const float sv = segs[sg * 32 + dl];
        if ((dir == 0) ? (sg < lgrp) : (sg > lgrp)) off += sv;
      }
#pragma unroll
      for (int li = 0; li < 8; ++li) bb[(lgrp * 8 + li) * 33 + dl] = lgv[li] + off;
    }
    vsync_l();
    {
      float qo[8], ko[8];
#pragma unroll
      for (int e = 0; e < 8; ++e) {
        const float bv = bb[li4 * 33 + d8 + e];
        qo[e] = q8[e] * 0.17677669529663687f * __expf(bv);
        ko[e] = k8[e] * __expf(-bv);
      }
      u32x4 qw, kw;
      qw.x = pack2(qo[0], qo[1]); qw.y = pack2(qo[2], qo[3]); qw.z = pack2(qo[4], qo[5]); qw.w = pack2(qo[6], qo[7]);
      kw.x = pack2(ko[0], ko[1]); kw.y = pack2(ko[2], ko[3]); kw.z = pack2(ko[4], ko[5]); kw.w = pack2(ko[6], ko[7]);
      *(u32x4*)(QiB + li4 * 40 + d8) = qw;
      *(u32x4*)(KiB + li4 * 40 + d8) = kw;
    }
    vsync_l();
    {
      bf16x8 qf[2];
#pragma unroll
      for (int ks = 0; ks < 2; ++ks) qf[ks] = *(const bf16x8*)(QiB + (it * 32 + r) * 40 + ks * 16 + h * 8);
      f32x16 sT[2];
#pragma unroll
      for (int jt = 0; jt < 2; ++jt) {
#pragma unroll
        for (int i = 0; i < 16; ++i) sT[jt][i] = 0.f;
#pragma unroll
        for (int ks = 0; ks < 2; ++ks) {
          const bf16x8 a = *(const bf16x8*)(KiB + (jt * 32 + r) * 40 + ks * 16 + h * 8);
          sT[jt] = MFMA32(a, qf[ks], sT[jt]);
        }
        const int ti = it * 32 + r;
#pragma unroll
        for (int i = 0; i < 16; ++i) {
          const int tj = jt * 32 + 8 * (i >> 2) + 4 * h + (i & 3);
          const bool keep = (dir == 0) ? (tj <= ti) : (tj >= ti);
          sT[jt][i] = keep ? sT[jt][i] : 0.f;
        }
      }
#pragma unroll
      for (int jt = 0; jt < 2; ++jt)
#pragma unroll
        for (int jj = 0; jj < 2; ++jj) {
          u32x4 pk;
          pk.x = pack2(sT[jt][8 * jj + 0], sT[jt][8 * jj + 1]); pk.y = pack2(sT[jt][8 * jj + 2], sT[jt][8 * jj + 3]);
          pk.z = pack2(sT[jt][8 * jj + 4], sT[jt][8 * jj + 5]); pk.w = pack2(sT[jt][8 * jj + 6], sT[jt][8 * jj + 7]);
          const bf16x8 pf = __builtin_bit_cast(bf16x8, pk);
          const int vsw = (((et * 32 + r) >> 3) & 7) << 3;
          const bfr* vrow = VtB + (et * 32 + r) * 72;
          s16x4 lo = *(const s16x4*)(vrow + ((jt * 32 + 16 * jj + 4 * h) ^ vsw));
          s16x4 hi = *(const s16x4*)(vrow + ((jt * 32 + 16 * jj + 4 * h + 8) ^ vsw));
          bf16x8 vf = __builtin_shufflevector(lo, hi, 0, 1, 2, 3, 4, 5, 6, 7);
          accO = MFMA32(vf, pf, accO);
        }
#pragma unroll
      for (int ks = 0; ks < 2; ++ks) {
        const bf16x8 a = *(const bf16x8*)(StB + (et * 32 + r) * 40 + ks * 16 + h * 8);
        accO = MFMA32(a, qf[ks], accO);
      }
    }
  }
  {
    float ss = 0.f;
#pragma unroll
    for (int i = 0; i < 16; ++i) ss += accO[i] * accO[i];
    ss += __shfl_xor(ss, 32);
    if (h == 0) ssq[w * 32 + r] = ss;
    vsync_l();
    const float tot = ssq[w * 32 + r] + ssq[(w ^ 2) * 32 + r];
    const float rstd = rsqrtf(tot * (1.f / 64.f) + 1e-6f);
    const size_t m = m0 + it * 32 + r;
    const float* ng = p.in[oidx(26)] + l * 64;
#pragma unroll
    for (int g4 = 0; g4 < 4; ++g4) {
      const int e0 = et * 32 + 8 * g4 + 4 * h;
      const uint2 rw = *(const uint2*)(P + m * PW + 2464 + hh * 64 + e0);
      const float rv[4] = {__uint_as_float(rw.x << 16), __uint_as_float(rw.x & 0xffff0000u), __uint_as_float(rw.y << 16), __uint_as_float(rw.y & 0xffff0000u)};
      float ov[4];
#pragma unroll
      for (int q = 0; q < 4; ++q) ov[q] = accO[4 * g4 + q] * rstd * ng[e0 + q] * (rv[q] * __builtin_amdgcn_rcpf(1.f + __expf(-rv[q])));
      uint2 pk; pk.x = pack2(ov[0], ov[1]); pk.y = pack2(ov[2], ov[3]);
      *(uint2*)(O + m * DM + 512 + hh * 64 + e0) = pk;
    }
  }
}

DI void shifted_load8(const bfr* P, int m, int t, int col, const float* mu, float (&o)[8]) {
  const bfr* row = P + (size_t)m * PW + col;
  const bool hp = (t != 0 && t != TL), hn = (t != TL - 1 && t != TT - 1);
  const u32x4 cur = *(const u32x4*)row;
  u32x4 prv = {0u, 0u, 0u, 0u}, nxt = {0u, 0u, 0u, 0u};
  if (hp) prv = *(const u32x4*)(row - PW);
  if (hn) nxt = *(const u32x4*)(row + PW);
  float x[8], xp[8], xn[8], m0v[8], m1v[8];
  unpack8(cur, x); unpack8(prv, xp); unpack8(nxt, xn);
  load8f(mu + col, m0v); load8f(mu + 1152 + col, m1v);
#pragma unroll
  for (int e = 0; e < 8; ++e) o[e] = x[e] + m0v[e] * (xp[e] - x[e]) + m1v[e] * (xn[e] - x[e]);
}

DN void rw_finish_tile(const Params& p, int l, int tile, char* smem) {
  const bfr* P = (const bfr*)(p.ws + OFF_P);
  const bfr* RWIN = (const bfr*)(p.ws + OFF_RWIN);
  const bfr* Y0 = (const bfr*)(p.ws + OFF_RWY);
  const bfr* Y1 = Y0 + (size_t)MR * 256;
  bfr* O = (bfr*)(p.ws + OFF_HO);
  const float* mu = p.in[oidx(10)] + (size_t)l * 2 * 1152;
  const int tid = otid();
  const int c0 = (tid & 31) * 8;
  float lng[8], lnb[8], rk[8], kaw[8];
  load8f(p.in[oidx(19)] + l * 256 + c0, lng); load8f(p.in[oidx(20)] + l * 256 + c0, lnb);
  load8f(p.in[oidx(18)] + l * 256 + c0, rk); load8f(p.in[oidx(17)] + l * 256 + c0, kaw);
#pragma unroll 1
  for (int ps = 0; ps < 2; ++ps) {
    const int m = tile * 16 + ps * 8 + (tid >> 5), t = m % TT;
    float y0[8], y1[8], af[8], ab[8], gt[8], rr[8], kx[8], vx[8];
    unpack8(*(const u32x4*)(Y0 + (size_t)m * 256 + c0), y0);
    unpack8(*(const u32x4*)(Y1 + (size_t)m * 256 + c0), y1);
    unpack8(*(const u32x4*)(RWIN + ((size_t)2 * MR + m) * 256 + c0), af);
    unpack8(*(const u32x4*)(RWIN + ((size_t)3 * MR + m) * 256 + c0), ab);
    unpack8(*(const u32x4*)(RWIN + ((size_t)4 * MR + m) * 256 + c0), gt);
    shifted_load8(P, m, t, c0, mu, rr);
    shifted_load8(P, m, t, 256 + c0, mu, kx);
    shifted_load8(P, m, t, 512 + c0, mu, vx);
    float sy = 0.f;
#pragma unroll
    for (int e = 0; e < 8; ++e) { y0[e] += y1[e]; sy += y0[e]; }
    const float mean = red8(sy) * (1.f / 64.f);
    float sv = 0.f, sd = 0.f;
#pragma unroll
    for (int e = 0; e < 8; ++e) {
      const float dl = y0[e] - mean; y0[e] = dl; sv += dl * dl;
      const float kds = kx[e] * (1.f + (af[e] - 1.f) * kaw[e]) + kx[e] * (1.f + (ab[e] - 1.f) * kaw[e]);
      sd += rr[e] * rk[e] * kds;
    }
    const float var = red8(sv) * (1.f / 64.f);
    const float sdot = red8(sd);
    const float rs = rsqrtf(var + 64e-5f);
    float ov[8];
#pragma unroll
    for (int e = 0; e < 8; ++e) ov[e] = (y0[e] * rs * lng[e] + lnb[e] + sdot * vx[e]) * gt[e];
    u32x4 ow; ow.x = pack2(ov[0], ov[1]); ow.y = pack2(ov[2], ov[3]); ow.z = pack2(ov[4], ov[5]); ow.w = pack2(ov[6], ov[7]);
    *(u32x4*)(O + (size_t)m * DM + c0) = ow;
  }
}

#define GSYNC() do { \
    asm volatile("s_waitcnt vmcnt(0)" ::: "memory");     \
    __syncthreads(); \
    gs_target += gridDim.x; \
    if (threadIdx.x == 0) { \
      unsigned* gbar_ = (unsigned*)(p.ws + OFF_CTR) + 32; \
      __builtin_amdgcn_fence(__ATOMIC_RELEASE, "agent"); \
      __hip_atomic_fetch_add(gbar_, 1u, __ATOMIC_RELAXED, __HIP_MEMORY_SCOPE_AGENT); \
      while ((int)(__hip_atomic_load(gbar_, __ATOMIC_RELAXED, __HIP_MEMORY_SCOPE_AGENT) - gs_target) < 0) __builtin_amdgcn_s_sleep(1); \
      __builtin_amdgcn_fence(__ATOMIC_ACQUIRE, "agent"); \
      asm volatile("s_waitcnt vmcnt(0)" ::: "memory");     \
    } \
    __syncthreads(); \
  } while (0)
#define EXP_G 1
__global__ void __launch_bounds__(512, 2) fwd_megakernel(Params p) {
  cg::grid_group grid = cg::this_grid();
  unsigned gs_target = 0;
  if (threadIdx.x < 8) ((int*)(dynlds + LDS_MISC_OFF))[threadIdx.x] = 0;
  __syncthreads();
#define smem ((char*)dynlds + vhalf() * 65536)
#define s_item ((volatile int*)(dynlds + LDS_MISC_OFF) + 4 + vhalf())
#define ctr ((unsigned*)(p.ws + OFF_CTR))

  convert_weights(p, 0, smem);
  compute_mod(p, smem);
  compute_rope(p);
  if (blockIdx.x == 0 && threadIdx.x < 24) ctr[threadIdx.x] = 0u;
  if (blockIdx.x == 0 && threadIdx.x == 32) ctr[32] = 0u;
  grid.sync();

#pragma unroll 1
  for (int l = 0; l < 2; ++l) {
    const bool need_ctx = (l == 0);
    if (l == 1) convert_weights(p, 1, smem);
#pragma unroll 1
    for (int r2 = 0; r2 < EXP_G; ++r2) {
    norm_phase(p, l, 0, l == 0, false);
    GSYNC();
    phase_g1(p);
    GSYNC();
    }
    phase_prep(p, l, smem);
    GSYNC();
#pragma unroll 1
    for (int r2 = 0; r2 < EXP_G; ++r2) {
    phase_lora(p, l);
    GSYNC();
    }
#ifndef EXP_MIX
#define EXP_MIX 1
#define EXP_MODE 1
#define EXP_TOTAL (n_rw)
#define EXP_FIN 1
#endif
#pragma unroll 1
    for (int rep = 0; rep < EXP_MIX; ++rep) {
      const int n_rw = 128, n_gla = 64, n_da = 512, n_gq = 512;
      const int n_dac = need_ctx ? 64 : 0, n_gqc = need_ctx ? 64 : 0;
      const int total = n_gla + n_da + n_gq + n_dac + n_gqc;
      for (int it = blockIdx.x; it < n_rw; it += gridDim.x) rw_scan_item(p, l, it, need_ctx, rep == 0 ? 0 : EXP_MODE);
      volatile int* s_blk = (volatile int*)(dynlds + LDS_MISC_OFF) + 8;
      const int xcd = (int)(__builtin_amdgcn_s_getreg((3 << 11) | 20) & 7u);
      const int QL = 136 + (need_ctx ? 16 : 0);
      int xo = 0;
      (void)total;
      for (;;) {
        __syncthreads();
        if (threadIdx.x == 0) {
          int got = -1, gq_ = 0;
          while (xo < 8) {
            const int q = (xcd + xo) & 7;
            const int k = (int)atomicAdd(&ctr[8 + l * 8 + q], 1u);
            if (k < QL) { got = k; gq_ = q; break; }
            ++xo;
          }
          s_blk[0] = got; s_blk[1] = gq_;
        }
        __syncthreads();
        int k = s_blk[0];
        const int q = s_blk[1];
        if (k < 0) break;
        if (k < 8) { gla_state_item(p, l, (k * 8 + q) * 2 + vhalf(), smem); continue; }
        k -= 8;
        if (k < 64) { const int g = (k >> 3) * 8 + q, qt = k & 7, b = g >> 2, hd = g & 3; da_item(p, l, b, hd, qt * 256, 0, 36, smem); continue; }
        k -= 64;
        if (k < 64) { const int g = (k >> 4) * 8 + q, sub = k & 15, b = g >> 1, hq = (g & 1) * 2 + (sub >> 3), qt = sub & 7; gqa_item(p, b, hq, qt * 256, 0, 36, smem); continue; }
        k -= 64;
        if (k < 8) { const int e = k * 8 + q, hd = e & 3, b = e >> 2; da_item(p, l, b, hd, TL, TL, 4, smem); continue; }
        k -= 8;
        { const int e = k * 8 + q, hq = e & 3, b = e >> 2; gqa_item(p, b, hq, TL, TL, 4, smem); }
      }
    }
    GSYNC();
#ifndef EXP_FIN
#define EXP_FIN 1
#endif
#pragma unroll 1
    for (int repf = 0; repf < EXP_FIN; ++repf) {
      const int n_rwf = MR / 16;
      const int n_glaf = NB * 36 * 4;
      for (int it = VB(); it < n_rwf + n_glaf; it += NVB()) {
        if (it < n_rwf) {
          int m0 = it * 16;
          if (!need_ctx && (m0 % TT) >= TL) continue;
          rw_finish_tile(p, l, it, smem);
        } else {
          int i2 = it - n_rwf;
          int hh = i2 & 3, cs = (i2 >> 2) % 36, b = (i2 >> 2) / 36;
          if (!need_ctx && cs >= 32) continue;
          gla_finish_item(p, l, b, cs, hh, smem);
        }
      }
    }
    GSYNC();
    phase_resid_gemm(p, l, (const bfr*)(p.ws + OFF_HO), (const bfr*)(p.ws + OFF_WOUT), DM, 2, l == 0, !need_ctx);
    GSYNC();
#pragma unroll 1
    for (int r2 = 0; r2 < EXP_G; ++r2) {
    norm_phase(p, l, 1, false, !need_ctx);
    GSYNC();
    phase_g3(p, l, !need_ctx);
    GSYNC();
    }
    fix_own_tiles(p, l, !need_ctx);
    phase_resid_gemm(p, l, (const bfr*)(p.ws + OFF_A2), (const bfr*)(p.ws + OFF_WDN), DFF, 5, false, !need_ctx);
    GSYNC();
  }
}

extern "C" void kernel_launch(void* const* d_in, const int* in_sizes, int n_in,
                              void* d_out, int out_size, void* d_ws, size_t ws_size,
                              hipStream_t stream) {
  static int grid_blocks = 0;
  if (!grid_blocks) {
    int dev = 0, cus = 0, per_cu = 0;
    (void)hipGetDevice(&dev);
    (void)hipDeviceGetAttribute(&cus, hipDeviceAttributeMultiprocessorCount, dev);
    if (hipFuncSetAttribute((const void*)fwd_megakernel, hipFuncAttributeMaxDynamicSharedMemorySize, LDS_BYTES) != hipSuccess)
      fprintf(stderr, "hipFuncSetAttribute failed\n");
    (void)hipOccupancyMaxActiveBlocksPerMultiprocessor(&per_cu, fwd_megakernel, 512, LDS_BYTES);
    (void)hipGetLastError();
    grid_blocks = cus;
  }
  Params p{};
  for (int i = 0; i < 32; ++i) p.in[i] = (const float*)d_in[i];
  p.out = (float*)d_out;
  p.ws = (char*)d_ws;
  void* args[] = {&p};
  hipError_t e = hipLaunchCooperativeKernel((void*)fwd_megakernel, dim3(grid_blocks), dim3(512), args, LDS_BYTES, stream);
  if (e != hipSuccess) fprintf(stderr, "cooperative launch failed: %s (grid %d)\n", hipGetErrorString(e), grid_blocks);
}
```

```cpp
#include <hip/hip_runtime.h>
#include <hip/hip_bf16.h>
#include <hip/hip_cooperative_groups.h>
#include <cstdio>
namespace cg = cooperative_groups;

#define DI __device__ __forceinline__
#define DN __device__ __forceinline__
#define LAS __attribute__((address_space(3)))
extern __shared__ __attribute__((aligned(16))) unsigned char dynlds[];
constexpr int LDS_RING = 131072, LDS_BD_OFF = 131072, LDS_MISC_OFF = 131072 + 4096, LDS_PARAMS_OFF = 131072 + 4096 + 256, LDS_BYTES = 131072 + 4096 + 256 + 512;
DI int otid() { int t = threadIdx.x & 255; asm volatile("" : "+v"(t)); return t; }
DI int oidx(int i) { asm volatile("" : "+s"(i)); return i; }
DI int vhalf() { int h = __builtin_amdgcn_readfirstlane(threadIdx.x >> 8); asm volatile("" : "+s"(h)); return h; }
DI int VB() { return blockIdx.x * 2 + vhalf(); }
DI int NVB() { return gridDim.x * 2; }
DI void vsync() {
  __builtin_amdgcn_fence(__ATOMIC_RELEASE, "workgroup");
  if ((threadIdx.x & 63) == 0) {
    int* bar = (int*)(dynlds + LDS_MISC_OFF) + (threadIdx.x >> 8);
    int old = __hip_atomic_fetch_add(bar, 1, __ATOMIC_RELAXED, __HIP_MEMORY_SCOPE_WORKGROUP);
    int tgt = (old & ~3) + 4;
    while (__hip_atomic_load(bar, __ATOMIC_RELAXED, __HIP_MEMORY_SCOPE_WORKGROUP) - tgt < 0) __builtin_amdgcn_s_sleep(1);
  }
  __builtin_amdgcn_fence(__ATOMIC_ACQUIRE, "workgroup");
}
typedef unsigned short bfr;
typedef __attribute__((ext_vector_type(8))) short bf16x8;
typedef __attribute__((ext_vector_type(4))) short s16x4;
typedef __attribute__((ext_vector_type(16))) float f32x16;
typedef __attribute__((ext_vector_type(4))) unsigned u32x4;
typedef __attribute__((ext_vector_type(2))) float f32x2;
typedef __attribute__((ext_vector_type(4))) float f32x4v;
#define MFMA32(a, b, c) __builtin_amdgcn_mfma_f32_32x32x16_bf16((a), (b), (c), 0, 0, 0)

constexpr int NB = 16, TL = 2048, TC = 256, TT = 2304, DM = 1024, MR = NB * TT;
constexpr int PW = 3264, NINP = 3328, DFF = 2816;
constexpr int SMEM_BYTES = 55296;

constexpr size_t OFF_WIN = 0;
constexpr size_t SZ_WIN = (size_t)NINP * DM * 2;
constexpr size_t OFF_WOUT = OFF_WIN + SZ_WIN;
constexpr size_t SZ_WOUT = (size_t)DM * DM * 2;
constexpr size_t OFF_WUP = OFF_WOUT + SZ_WOUT;
constexpr size_t SZ_WUP = (size_t)2 * DFF * DM * 2;
constexpr size_t OFF_WDN = OFF_WUP + SZ_WUP;
constexpr size_t SZ_WDN = (size_t)DM * DFF * 2;
constexpr size_t OFF_WLORA = OFF_WDN + SZ_WDN;
constexpr size_t SZ_WLORA = (size_t)1280 * 384 * 2;
constexpr size_t OFF_MOD = OFF_WLORA + SZ_WLORA;
constexpr size_t SZ_MOD = (size_t)2 * 17 * 6144 * 4;
constexpr size_t OFF_XC = OFF_MOD + SZ_MOD;
constexpr size_t SZ_XC = (size_t)NB * TC * DM * 4;
constexpr size_t OFF_ROPE = OFF_XC + SZ_XC;
constexpr size_t SZ_ROPE = (size_t)TL * 96 * 4;
constexpr size_t OFF_CTR = OFF_ROPE + SZ_ROPE;
constexpr size_t SZ_CTR = 256;
constexpr size_t OFF_HO = OFF_CTR + SZ_CTR;
constexpr size_t SZ_HO = (size_t)MR * DM * 2;
constexpr size_t OFF_P = OFF_HO + SZ_HO;
constexpr size_t SZ_P = (size_t)MR * PW * 2;
constexpr size_t OFF_RWIN = OFF_P + SZ_P;
constexpr size_t SZ_RWIN = (size_t)5 * MR * 256 * 2;
constexpr size_t OFF_RWY = OFF_RWIN + SZ_RWIN;
constexpr size_t SZ_RWY = (size_t)2 * MR * 256 * 2;
constexpr size_t OFF_GS = OFF_RWY + SZ_RWY;
constexpr size_t SZ_GS = (size_t)NB * 36 * 4 * 2 * 2048 * 4;
constexpr size_t WS_TOTAL = OFF_GS + SZ_GS;
static_assert(WS_TOTAL <= (size_t)536870912, "workspace too large");
constexpr size_t OFF_A2 = OFF_P;
constexpr size_t OFF_EDGE = OFF_RWIN;

struct Params {
  const float* in[32];
  float* out;
  char* ws;
};

DI void vsync_l() {
  asm volatile("s_waitcnt lgkmcnt(0)" ::: "memory");
  if ((threadIdx.x & 63) == 0) {
    int* bar = (int*)(dynlds + LDS_MISC_OFF) + (threadIdx.x >> 8);
    int old = __hip_atomic_fetch_add(bar, 1, __ATOMIC_RELAXED, __HIP_MEMORY_SCOPE_WORKGROUP);
    int tgt = (old & ~3) + 4;
    while (__hip_atomic_load(bar, __ATOMIC_RELAXED, __HIP_MEMORY_SCOPE_WORKGROUP) - tgt < 0) __builtin_amdgcn_s_sleep(1);
  }
  asm volatile("" ::: "memory");
}
DI bfr f2bf(float x) { unsigned u = __float_as_uint(x); u += 0x7fffu + ((u >> 16) & 1u); return (bfr)(u >> 16); }
DI float bf2f(bfr u) { return __uint_as_float(((unsigned)u) << 16); }
DI unsigned pack2(float a, float b) { unsigned r; asm volatile("v_cvt_pk_bf16_f32 %0, %1, %2" : "=v"(r) : "v"(a), "v"(b)); return r; }
template <int CTRL> DI float dppf(float x) {
  return __builtin_bit_cast(float, __builtin_amdgcn_mov_dpp(__builtin_bit_cast(int, x), CTRL, 0xf, 0xf, true));
}
DI float wave_sum(float v) {
  v += dppf<0xB1>(v); v += dppf<0x4E>(v); v += dppf<0x141>(v); v += dppf<0x140>(v);
  const float r0 = __builtin_bit_cast(float, __builtin_amdgcn_readlane(__builtin_bit_cast(int, v), 0));
  const float r1 = __builtin_bit_cast(float, __builtin_amdgcn_readlane(__builtin_bit_cast(int, v), 16));
  const float r2 = __builtin_bit_cast(float, __builtin_amdgcn_readlane(__builtin_bit_cast(int, v), 32));
  const float r3 = __builtin_bit_cast(float, __builtin_amdgcn_readlane(__builtin_bit_cast(int, v), 48));
  return (r0 + r1) + (r2 + r3);
}
DI float red8(float x) { x += dppf<0xB1>(x); x += dppf<0x4E>(x); x += dppf<0x141>(x); return x; }
DI float sigmoidf_(float x) { return 1.f / (1.f + expf(-x)); }
DI float softplusf_(float z) { return fmaxf(z, 0.f) + log1pf(expf(-fabsf(z))); }

DI const float* in_row(const Params& p, int b, int t) {
  return t < TL ? p.in[oidx(0)] + ((size_t)b * TL + t) * DM : p.in[oidx(2)] + ((size_t)b * TC + (t - TL)) * DM;
}
DI float* res_row(const Params& p, int b, int t) {
  return t < TL ? p.out + ((size_t)b * TL + t) * DM : (float*)(p.ws + OFF_XC) + ((size_t)b * TC + (t - TL)) * DM;
}

DN void convert_weights(const Params& p, int l, char* smem) {
  float* tile68 = (float*)smem;
  const int tid = otid();
  const int T_IN = 52 * 16, T_OUT = 16 * 16, T_UP = 88 * 16, T_DN = 16 * 44;
  const int total = T_IN + T_OUT + T_UP + T_DN;
  for (int it = VB(); it < total; it += NVB()) {
    const float* src; int ld, ldd, n0, k0, mode, nvalid; bfr* dst;
    if (it < T_IN) { int nt = it / 16, kt = it % 16; src = p.in[oidx(8)] + (size_t)l * DM * 3232; ld = 3232; nvalid = 3232; dst = (bfr*)(p.ws + OFF_WIN); ldd = DM; n0 = nt * 64; k0 = kt * 64; mode = 0; }
    else if (it < T_IN + T_OUT) { int i2 = it - T_IN; int nt = i2 / 16, kt = i2 % 16; src = p.in[oidx(9)] + (size_t)l * DM * DM; ld = DM; nvalid = DM; dst = (bfr*)(p.ws + OFF_WOUT); ldd = DM; n0 = nt * 64; k0 = kt * 64; mode = 0; }
    else if (it < T_IN + T_OUT + T_UP) { int i2 = it - T_IN - T_OUT; int nt = i2 / 16, kt = i2 % 16; src = p.in[oidx(28)] + (size_t)l * DM * 2 * DFF; ld = 2 * DFF; nvalid = 2 * DFF; dst = (bfr*)(p.ws + OFF_WUP); ldd = DM; n0 = nt * 64; k0 = kt * 64; mode = 1; }
    else { int i2 = it - T_IN - T_OUT - T_UP; int nt = i2 / 44, kt = i2 % 44; src = p.in[oidx(31)] + (size_t)l * DFF * DM; ld = DM; nvalid = DM; dst = (bfr*)(p.ws + OFF_WDN); ldd = DFF; n0 = nt * 64; k0 = kt * 64; mode = 0; }
#pragma unroll
    for (int i = 0; i < 4; ++i) {
      const int c = tid + 256 * i, kl = c >> 4, n4 = (c & 15) * 4;
      const int n = n0 + n4;
      int sc = n;
      if (mode == 1) { int grp = n >> 8, within = n & 255; sc = ((within >= 128) ? DFF : 0) + grp * 128 + (within & 127); }
      f32x4v v = {0.f, 0.f, 0.f, 0.f};
      if (sc < nvalid) v = *(const f32x4v*)(src + (size_t)(k0 + kl) * ld + sc);
      *(f32x4v*)(&tile68[kl * 68 + n4]) = v;
    }
    vsync();
#pragma unroll
    for (int i = 0; i < 2; ++i) {
      const int c = tid + 256 * i, nl = c & 63, k8 = (c >> 6) * 8;
      float t8[8];
#pragma unroll
      for (int e = 0; e < 8; ++e) t8[e] = tile68[(k8 + e) * 68 + nl];
      u32x4 ow; ow.x = pack2(t8[0], t8[1]); ow.y = pack2(t8[2], t8[3]); ow.z = pack2(t8[4], t8[5]); ow.w = pack2(t8[6], t8[7]);
      *(u32x4*)(dst + (size_t)(n0 + nl) * ldd + k0 + k8) = ow;
    }
    vsync();
  }
  {
    bfr* WL = (bfr*)(p.ws + OFF_WLORA);
    const float* w2 = p.in[oidx(12)] + (size_t)l * 2 * 64 * 256;
    const float* a2 = p.in[oidx(14)] + (size_t)l * 2 * 64 * 256;
    const float* g2 = p.in[oidx(15)] + (size_t)l * 128 * 256;
    for (int i = VB() * 256 + tid; i < 1280 * 384; i += NVB() * 256) {
      int n = i / 384, k = i - n * 384;
      int kind = n >> 8, c = n & 255;
      float v = 0.f;
      if (kind < 4) { int kb = k - kind * 64; if (kb >= 0 && kb < 64 && k < 256) v = (kind < 2) ? w2[((size_t)kind * 64 + kb) * 256 + c] : a2[((size_t)(kind - 2) * 64 + kb) * 256 + c]; }
      else { if (k >= 256) v = g2[(size_t)(k - 256) * 256 + c]; }
      WL[i] = f2bf(v);
    }
  }
}

DN void compute_mod(const Params& p, char* smem) {
  float* sc = (float*)smem;
  float* red = sc + 17 * 256;
  const int tid = otid();
  float* MOD = (float*)(p.ws + OFF_MOD);
  for (int it = VB(); it < 192; it += NVB()) {
    int l = it / 96, nb = it % 96;
    int col = nb * 64 + (tid & 63), kg = tid >> 6;
    const float* W = p.in[oidx(4)] + (size_t)l * DM * 6144;
    float acc[17];
#pragma unroll
    for (int r = 0; r < 17; ++r) acc[r] = 0.f;
    for (int kc = 0; kc < 4; ++kc) {
      vsync();
      for (int i = tid; i < 17 * 256; i += 256) {
        int r = i >> 8, k = i & 255;
        float c = (r < 16) ? p.in[oidx(1)][r * DM + kc * 256 + k] : p.in[oidx(3)][kc * 256 + k];
        sc[i] = c / (1.f + expf(-c));
      }
      vsync();
#pragma unroll 1
      for (int kk0 = 0; kk0 < 64; kk0 += 16) {
        float wv[16];
#pragma unroll
        for (int u = 0; u < 16; ++u) wv[u] = W[(size_t)(kc * 256 + kg * 64 + kk0 + u) * 6144 + col];
#pragma unroll
        for (int u = 0; u < 16; ++u) {
#pragma unroll
          for (int r = 0; r < 17; ++r) acc[r] += sc[r * 256 + kg * 64 + kk0 + u] * wv[u];
        }
      }
    }
    vsync();
#pragma unroll
    for (int r = 0; r < 17; ++r) red[(kg * 17 + r) * 64 + (tid & 63)] = acc[r];
    vsync();
    for (int i = tid; i < 17 * 64; i += 256) {
      int r = i >> 6, cl = i & 63;
      float s = red[(0 * 17 + r) * 64 + cl] + red[(1 * 17 + r) * 64 + cl] + red[(2 * 17 + r) * 64 + cl] + red[(3 * 17 + r) * 64 + cl];
      MOD[(size_t)(l * 17 + r) * 6144 + nb * 64 + cl] = s + p.in[oidx(5)][l * 6144 + nb * 64 + cl];
    }
  }
}

DN void compute_rope(const Params& p) {
  float* rope = (float*)(p.ws + OFF_ROPE);
  const int gtid = VB() * 256 + otid(), gsz = NVB() * 256;
  for (int i = gtid; i < TL * 48; i += gsz) {
    int t = i / 48, e = i % 48;
    int row = t >> 6, col = t & 63;
    int nf, idx;
    if (e < 16) { nf = 8; idx = e; } else { nf = 16; idx = e - 16; }
    int fi = idx % nf;
    float pos = (idx < nf) ? (float)row : (float)col;
    float inv = exp2f(-(float)fi / (float)nf * 13.287712379549449f);
    float ang = pos * inv;
    float cs = cosf(ang), sn = sinf(ang);
    if (e < 16) { rope[t * 96 + e] = cs; rope[t * 96 + 16 + e] = sn; }
    else { rope[t * 96 + 32 + idx] = cs; rope[t * 96 + 64 + idx] = sn; }
  }
}

DN void norm_phase(const Params& p, int l, int which, bool from_input, bool skip_ctx) {
  const int tid = otid(), lane = tid & 63;
  const int wave = (VB() * 256 + tid) >> 6, nw = NVB() * 4;
  const float* g = p.in[oidx(6) + which] + l * DM;
  const float* MOD = (const float*)(p.ws + OFF_MOD);
  bfr* H = (bfr*)(p.ws + OFF_HO);
  for (int m0 = wave * 4; m0 < MR; m0 += nw * 4) {
    f32x4v v[4][4];
    float ss[4];
    bool act[4];
    const float* modp[4];
#pragma unroll
    for (int q = 0; q < 4; ++q) {
      const int m = m0 + q;
      const int b = m / TT, t = m - b * TT;
      const bool isctx = t >= TL;
      act[q] = !(isctx && skip_ctx);
      const float* src = from_input ? in_row(p, b, t) : res_row(p, b, t);
      modp[q] = MOD + (size_t)(l * 17 + (isctx ? 16 : b)) * 6144;
      ss[q] = 0.f;
      if (act[q]) {
#pragma unroll
        for (int i = 0; i < 4; ++i) {
          v[q][i] = *(const f32x4v*)(src + i * 256 + lane * 4);
          ss[q] += v[q][i].x * v[q][i].x + v[q][i].y * v[q][i].y + v[q][i].z * v[q][i].z + v[q][i].w * v[q][i].w;
        }
      } else {
#pragma unroll
        for (int i = 0; i < 4; ++i) v[q][i] = (f32x4v){0.f, 0.f, 0.f, 0.f};
      }
    }
#pragma unroll
    for (int q = 0; q < 4; ++q) {
      if (!act[q]) continue;
      const int m = m0 + q;
      const float* shift = modp[q] + (which ? 3 : 0) * DM;
      const float* scale = modp[q] + (which ? 4 : 1) * DM;
      const float tot = wave_sum(ss[q]);
      const float rstd = rsqrtf(tot * (1.f / DM) + 1e-6f);
#pragma unroll
      for (int i = 0; i < 4; ++i) {
        const int k = i * 256 + lane * 4;
        const f32x4v gg = *(const f32x4v*)(g + k), sc = *(const f32x4v*)(scale + k), sh = *(const f32x4v*)(shift + k);
        const float o0 = (v[q][i].x * rstd * gg.x) * (1.f + sc.x) + sh.x;
        const float o1 = (v[q][i].y * rstd * gg.y) * (1.f + sc.y) + sh.y;
        const float o2 = (v[q][i].z * rstd * gg.z) * (1.f + sc.z) + sh.z;
        const float o3 = (v[q][i].w * rstd * gg.w) * (1.f + sc.w) + sh.w;
        uint2 pk; pk.x = pack2(o0, o1); pk.y = pack2(o2, o3);
        *(uint2*)(H + (size_t)m * DM + k) = pk;
      }
    }
  }
}

namespace pg8 {
#define PG8_LAS __attribute__((address_space(3)))
typedef unsigned short bf16_t;
typedef short bf16x8 __attribute__((ext_vector_type(8)));
typedef float f32x4 __attribute__((ext_vector_type(4)));
typedef unsigned u32x4 __attribute__((ext_vector_type(4)));
constexpr int BM = 256, BK = 64, HALF = 128, HTB = HALF * BK * 2  , STAGE_BYTES = 8 * HTB, NXCD = 8, WGM = 8;

__host__ __device__ __forceinline__ int lds_byte(int r, int c) { const int st = (r >> 4) * 2 + (c >> 5), rr = r & 15, cc = c & 31, ob = rr * 64 + cc * 2; return st * 1024 + (ob ^ (((ob >> 9) & 1) << 5)); }
__host__ __device__ __forceinline__ void stage_rc(int b, int& R, int& C) { const int st = b / 1024, sb = b % 1024, swz = sb ^ (((sb >> 9) & 1) << 5); R = (st >> 1) * 16 + swz / 64; C = (st & 1) * 32 + (swz % 64) / 2; }
__host__ __device__ __forceinline__ int perm32(int rho) { const int n = rho >> 4, i = rho & 15; return 8 * (i >> 2) + 4 * n + (i & 3); }

struct Unit { int pm, pn; int kofs = 0; };
struct Gemm { const bf16_t* A; const bf16_t* Bt; int M, N, K; int ntov = 0; };

__device__ __forceinline__ unsigned cvt_pk_bf16(float lo, float hi) { unsigned r; asm volatile("v_cvt_pk_bf16_f32 %0, %1, %2" : "=v"(r) : "v"(lo), "v"(hi)); return r; }
template <class Epi, class Sched, bool ALIGN_EPI = false, bool SP2 = false>
__device__ __forceinline__ void gemm_phase(PG8_LAS unsigned char* lds, const Gemm g, const Sched& S, const Epi& E) {
    int tid_ = threadIdx.x; asm volatile("" : "+v"(tid_));
    const int tid = tid_, wid = __builtin_amdgcn_readfirstlane(tid >> 6), lane = tid & 63, wr = wid >> 2, wc = wid & 3, fr = lane & 15, fq = lane >> 4;
    const int K = g.K, nt = g.ntov ? g.ntov : K / BK;
    unsigned voffA[2], voffB[2];
#pragma unroll
    for (int i = 0; i < 2; ++i) { int R, C; stage_rc(tid * 16 + i * 8192, R, C); const int Rb = Epi::PERM ? ((R & ~31) + perm32(R & 31)) : R;
        voffA[i] = (unsigned)(R * K + C) * 2u; voffB[i] = (unsigned)(Rb * K + C) * 2u; }
    const size_t kstep = (size_t)(BK * 2);
    const size_t hstep = (size_t)HALF * K * 2;
    const size_t tstep = 2 * hstep;
    const unsigned ldsw = (unsigned)wid * 1024u;
    const int aoff = lds_byte(wr * 64 + fr, fq * 8), boff = lds_byte(wc * 32 + fr, fq * 8);
#define PG8_SA(b, h) (((b) * 2 + (h)) * HTB)
#define PG8_SB(b, h) ((4 + (b) * 2 + (h)) * HTB)
#define PG8_STAGE(bufoff, gbase, voff) do { _Pragma("unroll") for (int _i = 0; _i < 2; ++_i) \
        __builtin_amdgcn_global_load_lds((const unsigned*)((const char*)(gbase) + (voff)[_i]), (PG8_LAS unsigned*)(lds + (bufoff) + ldsw + _i * 8192), 16, 0, 0); } while (0)
#define PG8_LDA(dst, b, h) do { _Pragma("unroll") for (int m = 0; m < 4; ++m) _Pragma("unroll") for (int k = 0; k < 2; ++k) dst[m][k] = *(const PG8_LAS bf16x8*)(lds + PG8_SA(b, h) + aoff + m * 2048 + k * 1024); } while (0)
#define PG8_LDB(dst, b, h) do { _Pragma("unroll") for (int n = 0; n < 2; ++n) _Pragma("unroll") for (int k = 0; k < 2; ++k) dst[n][k] = *(const PG8_LAS bf16x8*)(lds + PG8_SB(b, h) + boff + n * 2048 + k * 1024); } while (0)
#define PG8_MMA(ai, bj, At, Bt) do { __builtin_amdgcn_s_setprio(1); _Pragma("unroll") for (int m = 0; m < 4; ++m) _Pragma("unroll") for (int n = 0; n < 2; ++n) _Pragma("unroll") for (int k = 0; k < 2; ++k) \
        acc[ai][bj][m][n] = __builtin_amdgcn_mfma_f32_16x16x32_bf16(Bt[n][k], At[m][k], acc[ai][bj][m][n], 0, 0, 0); __builtin_amdgcn_s_setprio(0); } while (0)
#define PG8_WAIT_V(n) asm volatile("s_waitcnt vmcnt(" #n ")" ::: "memory")
#define PG8_WAIT_L(n) asm volatile("s_waitcnt lgkmcnt(" #n ")" ::: "memory")
#define PG8_BAR __builtin_amdgcn_s_barrier()
#define PG8_SCHED __builtin_amdgcn_sched_barrier(0)
    Unit cur, nxt; int ui = 0;
    if (!S.next(0, cur)) return;
    f32x4 acc[2][2][4][2];
#pragma unroll
    for (int a = 0; a < 2; ++a)
#pragma unroll
        for (int b = 0; b < 2; ++b)
#pragma unroll
            for (int m = 0; m < 4; ++m)
#pragma unroll
                for (int n = 0; n < 2; ++n) acc[a][b][m][n] = (f32x4){0.f, 0.f, 0.f, 0.f};
    bf16x8 At[4][2], B0[2][2], B1[2][2];
    const char* cA = (const char*)g.A + (size_t)cur.pm * tstep + 2 * cur.kofs; const char* cB = (const char*)g.Bt + (size_t)cur.pn * tstep + 2 * cur.kofs;
    S.a_ready(cur);
    if constexpr (SP2) {
        PG8_STAGE(PG8_SB(0, 0), cB, voffB); PG8_STAGE(PG8_SB(0, 1), cB + hstep, voffB); PG8_STAGE(PG8_SA(0, 0), cA, voffA); PG8_STAGE(PG8_SA(0, 1), cA + hstep, voffA);
        if (wr == 1) PG8_BAR;
        PG8_WAIT_V(2); PG8_BAR;
        PG8_STAGE(PG8_SB(1, 0), cB + kstep, voffB); PG8_STAGE(PG8_SA(1, 0), cA + kstep, voffA); PG8_STAGE(PG8_SB(1, 1), cB + hstep + kstep, voffB);
        PG8_WAIT_V(6); PG8_BAR;
    } else {
        PG8_STAGE(PG8_SB(0, 0), cB, voffB); PG8_STAGE(PG8_SA(0, 0), cA, voffA); PG8_STAGE(PG8_SB(0, 1), cB + hstep, voffB); PG8_STAGE(PG8_SA(0, 1), cA + hstep, voffA);
        if (wr == 1) PG8_BAR;
        PG8_WAIT_V(4); PG8_BAR;
        PG8_STAGE(PG8_SB(1, 0), cB + kstep, voffB); PG8_STAGE(PG8_SA(1, 0), cA + kstep, voffA); PG8_STAGE(PG8_SB(1, 1), cB + hstep + kstep, voffB);
        PG8_WAIT_V(6); PG8_BAR;
    }
    for (;;) {
        const bool has_next = S.next(ui + 1, nxt);
        const char* nA = has_next ? (const char*)g.A + (size_t)nxt.pm * tstep + 2 * nxt.kofs : cA; const char* nB = has_next ? (const char*)g.Bt + (size_t)nxt.pn * tstep + 2 * nxt.kofs : cB;
        for (int t = 0; t < nt; t += 2) {
            const bool last = (t == nt - 2);
            const char* a1 = cA + (size_t)(t + 1) * kstep;
            const char* a2 = last ? nA : cA + (size_t)(t + 2) * kstep; const char* b2 = last ? nB : cB + (size_t)(t + 2) * kstep;
            const char* a3 = a2 + kstep; const char* b3 = b2 + kstep;
            if (last && has_next) S.a_ready(nxt);
            if constexpr (SP2) {
            PG8_LDB(B0, 0, 0); PG8_LDB(B1, 0, 1); PG8_SCHED; PG8_LDA(At, 0, 0); PG8_STAGE(PG8_SA(1, 1), a1 + hstep, voffA);
            PG8_WAIT_V(8); PG8_WAIT_L(0); PG8_BAR; PG8_MMA(0, 0, At, B0); PG8_MMA(0, 1, At, B1); PG8_BAR; PG8_SCHED;
            PG8_LDA(At, 0, 1); PG8_STAGE(PG8_SB(0, 0), b2, voffB); PG8_STAGE(PG8_SB(0, 1), b2 + hstep, voffB); PG8_STAGE(PG8_SA(0, 0), a2, voffA);
            PG8_WAIT_V(8); PG8_WAIT_L(0); PG8_BAR; PG8_MMA(1, 0, At, B0); PG8_MMA(1, 1, At, B1); PG8_BAR; PG8_SCHED;
            PG8_LDB(B0, 1, 0); PG8_LDB(B1, 1, 1); PG8_SCHED; PG8_LDA(At, 1, 0); PG8_STAGE(PG8_SA(0, 1), a2 + hstep, voffA);
            PG8_WAIT_V(8); PG8_WAIT_L(0); PG8_BAR; PG8_MMA(0, 0, At, B0); PG8_MMA(0, 1, At, B1); PG8_BAR; PG8_SCHED;
            PG8_LDA(At, 1, 1); PG8_STAGE(PG8_SB(1, 0), b3, voffB); PG8_STAGE(PG8_SB(1, 1), b3 + hstep, voffB); PG8_STAGE(PG8_SA(1, 0), a3, voffA);
            PG8_WAIT_V(8); PG8_WAIT_L(0); PG8_BAR; PG8_MMA(1, 0, At, B0); PG8_MMA(1, 1, At, B1); PG8_BAR; PG8_SCHED;
            } else {
            PG8_LDB(B0, 0, 0); PG8_SCHED; PG8_LDA(At, 0, 0); PG8_STAGE(PG8_SA(1, 1), a1 + hstep, voffA);
            PG8_WAIT_L(8); PG8_BAR; PG8_WAIT_L(0); PG8_MMA(0, 0, At, B0); PG8_BAR; PG8_SCHED;
            PG8_LDB(B1, 0, 1); PG8_STAGE(PG8_SB(0, 0), b2, voffB);
            PG8_BAR; PG8_WAIT_L(0); PG8_MMA(0, 1, At, B1); PG8_BAR;
            PG8_LDA(At, 0, 1); PG8_STAGE(PG8_SA(0, 0), a2, voffA);
            PG8_BAR; PG8_WAIT_L(0); PG8_MMA(1, 0, At, B0); PG8_BAR; PG8_SCHED;
            PG8_STAGE(PG8_SB(0, 1), b2 + hstep, voffB);
            PG8_WAIT_V(6); PG8_BAR; PG8_MMA(1, 1, At, B1); PG8_BAR;
            PG8_LDB(B0, 1, 0); PG8_SCHED; PG8_LDA(At, 1, 0); PG8_STAGE(PG8_SA(0, 1), a2 + hstep, voffA);
            PG8_WAIT_L(8); PG8_BAR; PG8_WAIT_L(0); PG8_MMA(0, 0, At, B0); PG8_BAR; PG8_SCHED;
            PG8_LDB(B1, 1, 1); PG8_STAGE(PG8_SB(1, 0), b3, voffB);
            PG8_BAR; PG8_WAIT_L(0); PG8_MMA(0, 1, At, B1); PG8_BAR;
            PG8_LDA(At, 1, 1); PG8_STAGE(PG8_SA(1, 0), a3, voffA);
            PG8_BAR; PG8_WAIT_L(0); PG8_MMA(1, 0, At, B0); PG8_BAR; PG8_SCHED;
            PG8_STAGE(PG8_SB(1, 1), b3 + hstep, voffB);
            PG8_WAIT_V(6); PG8_BAR; PG8_MMA(1, 1, At, B1); PG8_BAR;
            }
        }
        if constexpr (ALIGN_EPI) { if (wr == 0) PG8_BAR; }
        if constexpr (!Epi::AFTER_DRAIN) { E(acc, cur, wr, wc, fr, fq); S.done(cur); }
        if (!has_next) break;
#pragma unroll
        for (int a = 0; a < 2; ++a)
#pragma unroll
            for (int b = 0; b < 2; ++b)
#pragma unroll
                for (int m = 0; m < 4; ++m)
#pragma unroll
                    for (int n = 0; n < 2; ++n) acc[a][b][m][n] = (f32x4){0.f, 0.f, 0.f, 0.f};
        cur = nxt; cA = nA; cB = nB; ++ui;
        if constexpr (ALIGN_EPI) { if (wr == 1) PG8_BAR; }
    }
    PG8_WAIT_V(0);
    if constexpr (!ALIGN_EPI) { if (wr == 0) PG8_BAR; }
    PG8_BAR;
    if constexpr (Epi::AFTER_DRAIN) { E.fused(acc, cur, wr, wc, fr, fq, lds, wid, lane); S.done(cur); }
#undef PG8_SA
#undef PG8_SB
#undef PG8_STAGE
#undef PG8_LDA
#undef PG8_LDB
#undef PG8_MMA
#undef PG8_WAIT_V
#undef PG8_WAIT_L
#undef PG8_BAR
#undef PG8_SCHED
}
}

struct MySched {
  int nM, nN, nwg, G, c; bool skip; bool lora = false;
  DI void init(int nM_, int nN_, int G_, int c_, bool skip_) { nM = nM_; nN = nN_; nwg = nM_ * nN_; G = G_; c = c_; skip = skip_; }
  DI bool next(int i, pg8::Unit& u) const {
    const long L = (long)i * G + c; if (L >= nwg) return false;
    int wgid = (int)L; { const int q = nwg / pg8::NXCD, r = nwg % pg8::NXCD, xcd = wgid % pg8::NXCD, off = wgid / pg8::NXCD; wgid = (xcd < r ? xcd * (q + 1) : r * (q + 1) + (xcd - r) * q) + off; }
    const int nig = pg8::WGM * nN, gid = wgid / nig, fm = gid * pg8::WGM, gsz = (nM - fm) < pg8::WGM ? (nM - fm) : pg8::WGM;
    const int pm = fm + ((wgid % nig) % gsz); u.pn = (wgid % nig) / gsz;
    u.pm = skip ? (pm >> 3) * 9 + (pm & 7) : pm;
    u.kofs = lora ? ((u.pn < 4) ? (u.pn >> 1) * 128 : 256) : 0;
    return true;
  }
  DI void a_ready(const pg8::Unit&) const {}
  DI void done(const pg8::Unit&) const {}
};

struct EpiP {
  static constexpr bool PERM = true, AFTER_DRAIN = false;
  bfr* P;
  DI void operator()(const pg8::f32x4 (&acc)[2][2][4][2], const pg8::Unit& u, int wr, int wc, int fr, int fq) const {
    const int row0 = u.pm * 256 + wr * 64 + fr, col0 = u.pn * 256 + wc * 32 + 8 * fq;
#pragma unroll
    for (int ai = 0; ai < 2; ++ai)
#pragma unroll
      for (int m = 0; m < 4; ++m) {
        bfr* rowp = P + (size_t)(row0 + ai * 128 + m * 16) * PW;
#pragma unroll
        for (int bj = 0; bj < 2; ++bj) {
          const int col = col0 + bj * 128;
          if (col < PW) {
            pg8::f32x4 v0 = acc[ai][bj][m][0], v1 = acc[ai][bj][m][1];
            u32x4 w; w.x = pg8::cvt_pk_bf16(v0[0], v0[1]); w.y = pg8::cvt_pk_bf16(v0[2], v0[3]); w.z = pg8::cvt_pk_bf16(v1[0], v1[1]); w.w = pg8::cvt_pk_bf16(v1[2], v1[3]);
            *(u32x4*)(rowp + col) = w;
          }
        }
      }
  }
};

struct EpiResid {
  static constexpr bool PERM = true, AFTER_DRAIN = false;
  const float* xin; const float* cin; float* xout; float* xc; const float* modl; int gi; bool src_input;
  DI void operator()(const pg8::f32x4 (&acc)[2][2][4][2], const pg8::Unit& u, int wr, int wc, int fr, int fq) const {
    const int row0 = u.pm * 256 + wr * 64 + fr, col0 = u.pn * 256 + wc * 32 + 8 * fq;
    const int b = (u.pm * 256) / TT;
#pragma unroll
    for (int ai = 0; ai < 2; ++ai)
#pragma unroll
      for (int m = 0; m < 4; ++m) {
        const int row = row0 + ai * 128 + m * 16;
        const int t = row - b * TT;
        const bool isc = t >= TL;
        float* dst = isc ? xc + ((size_t)b * TC + (t - TL)) * DM : xout + ((size_t)b * TL + t) * DM;
        const float* src = src_input ? (isc ? cin + ((size_t)b * TC + (t - TL)) * DM : xin + ((size_t)b * TL + t) * DM) : dst;
        const float* gate = modl + (size_t)(isc ? 16 : b) * 6144 + gi * DM;
#pragma unroll
        for (int bj = 0; bj < 2; ++bj) {
          const int col = col0 + bj * 128;
#pragma unroll
          for (int n = 0; n < 2; ++n) {
            pg8::f32x4 sv = *(const pg8::f32x4*)(src + col + 4 * n);
            pg8::f32x4 gv = *(const pg8::f32x4*)(gate + col + 4 * n);
            pg8::f32x4 o = sv + gv * acc[ai][bj][m][n];
            *(pg8::f32x4*)(dst + col + 4 * n) = o;
          }
        }
      }
  }
};

struct EpiFfn {
  static constexpr bool PERM = true, AFTER_DRAIN = false;
  bfr* A2; float* EDGE; const float* cw; const float* cb; LAS float* bd;
  DI void operator()(const pg8::f32x4 (&acc)[2][2][4][2], const pg8::Unit& u, int wr, int wc, int fr, int fq) const {
    const int jl = wc * 32 + 8 * fq;
    const int j0 = u.pn * 128 + jl;
    const int m0 = u.pm * 256;
    const int t0 = m0 % TT;
#pragma unroll
    for (int ai = 0; ai < 2; ++ai) {
      const int sl = ai * 2 + wr;
      if (fr == 0) { *(LAS pg8::f32x4*)(bd + (sl * 2 + 0) * 128 + jl) = acc[ai][1][0][0]; *(LAS pg8::f32x4*)(bd + (sl * 2 + 0) * 128 + jl + 4) = acc[ai][1][0][1]; }
      if (fr == 15) { *(LAS pg8::f32x4*)(bd + (sl * 2 + 1) * 128 + jl) = acc[ai][1][3][0]; *(LAS pg8::f32x4*)(bd + (sl * 2 + 1) * 128 + jl + 4) = acc[ai][1][3][1]; }
    }
    asm volatile("s_waitcnt lgkmcnt(0)" ::: "memory");
    __builtin_amdgcn_s_barrier();
    asm volatile("" ::: "memory");
    constexpr bool ror1_is_prev = true;
    unsigned keep[2][4][2];
#pragma unroll
    for (int n = 0; n < 2; ++n) {
      const pg8::f32x4 c0 = *(const pg8::f32x4*)(cw + j0 + 4 * n), c1 = *(const pg8::f32x4*)(cw + DFF + j0 + 4 * n), c2 = *(const pg8::f32x4*)(cw + 2 * DFF + j0 + 4 * n), cbv = *(const pg8::f32x4*)(cb + j0 + 4 * n);
#pragma unroll
      for (int ai = 0; ai < 2; ++ai) {
        const int sl = ai * 2 + wr;
        const pg8::f32x4 bprev = (sl > 0) ? *(const LAS pg8::f32x4*)(bd + ((sl - 1) * 2 + 1) * 128 + jl + 4 * n) : (pg8::f32x4){0.f, 0.f, 0.f, 0.f};
        const pg8::f32x4 bnext = (sl < 3) ? *(const LAS pg8::f32x4*)(bd + ((sl + 1) * 2 + 0) * 128 + jl + 4 * n) : (pg8::f32x4){0.f, 0.f, 0.f, 0.f};
#pragma unroll
        for (int m = 0; m < 4; ++m) {
          const int rl = ai * 128 + wr * 64 + m * 16 + fr;
          const int t = t0 + rl;
          const bool first = (t == 0) || (t == TL);
          const bool last = (t == TL - 1) || (t == TT - 1);
          const bool etop = (ai == 0 && m == 0) && (wr == 0) && (fr == 0) && !first;
          const bool ebot = (ai == 1 && m == 3) && (wr == 1) && (fr == 15) && !last;
          float ov[4];
#pragma unroll
          for (int e = 0; e < 4; ++e) {
            const float g = acc[ai][1][m][n][e], uv = acc[ai][0][m][n][e];
            const float xa = dppf<0x121>(g), xb = dppf<0x12F>(g);
            const float same_prev = ror1_is_prev ? xa : xb, same_next = ror1_is_prev ? xb : xa;
            float oprev, onext;
            if (m > 0) { const float pv = acc[ai][1][m > 0 ? m - 1 : 0][n][e]; const float pa = dppf<0x121>(pv), pb = dppf<0x12F>(pv); oprev = ror1_is_prev ? pa : pb; }
            else oprev = bprev[e];
            if (m < 3) { const float nv = acc[ai][1][m < 3 ? m + 1 : 3][n][e]; const float na = dppf<0x121>(nv), nb = dppf<0x12F>(nv); onext = ror1_is_prev ? nb : na; }
            else onext = bnext[e];
            const float gm = (fr == 0) ? oprev : same_prev;
            const float gp = (fr == 15) ? onext : same_next;
            if (etop) {
              float* ed = EDGE + ((size_t)(u.pm * 2 + 0) * DFF + j0 + 4 * n + e) * 3;
              ed[0] = c1[e] * g + c2[e] * gp + cbv[e]; ed[1] = uv; ed[2] = g;
            } else if (ebot) {
              float* ed = EDGE + ((size_t)(u.pm * 2 + 1) * DFF + j0 + 4 * n + e) * 3;
              ed[0] = c0[e] * gm + c1[e] * g + cbv[e]; ed[1] = uv; ed[2] = g;
            }
            const float z = c0[e] * gm + c1[e] * g + c2[e] * gp + cbv[e];
            ov[e] = z * __builtin_amdgcn_rcpf(1.f + __expf(-z)) * uv;
          }
          {
            const unsigned p0 = pg8::cvt_pk_bf16(ov[0], ov[1]), p1 = pg8::cvt_pk_bf16(ov[2], ov[3]);
            if (n == 0) { keep[ai][m][0] = p0; keep[ai][m][1] = p1; }
            else if (!etop && !ebot) {
              u32x4 w; w.x = keep[ai][m][0]; w.y = keep[ai][m][1]; w.z = p0; w.w = p1;
              *(u32x4*)(A2 + (size_t)(m0 + rl) * DFF + j0) = w;
            }
          }
        }
      }
    }
  }
};

struct EpiLora {
  static constexpr bool PERM = true, AFTER_DRAIN = false;
  bfr* RW; const float* w0; const float* a0;
  DI void operator()(const pg8::f32x4 (&acc)[2][2][4][2], const pg8::Unit& u, int wr, int wc, int fr, int fq) const {
    const int row0 = u.pm * 256 + wr * 64 + fr, cl = wc * 32 + 8 * fq;
    const int kind = u.pn;
    bfr* base = RW + (size_t)kind * MR * 256;
    const float osc = (kind < 2) ? 0.6065306597126334f : 1.f;
#pragma unroll
    for (int bj = 0; bj < 2; ++bj) {
      const int c0 = cl + bj * 128;
      float bias[8];
#pragma unroll
      for (int q = 0; q < 8; ++q) bias[q] = (kind < 2) ? w0[kind * 256 + c0 + q] : ((kind < 4) ? a0[(kind - 2) * 256 + c0 + q] : 0.f);
#pragma unroll
      for (int ai = 0; ai < 2; ++ai)
#pragma unroll
        for (int m = 0; m < 4; ++m) {
          float o[8];
#pragma unroll
          for (int n = 0; n < 2; ++n)
#pragma unroll
            for (int e = 0; e < 4; ++e) {
              const float x = acc[ai][bj][m][n][e] + bias[n * 4 + e];
              const float sg = osc * __builtin_amdgcn_rcpf(1.f + __expf(-x));
              o[n * 4 + e] = (kind < 4) ? sg : x;
            }
          u32x4 w; w.x = pg8::cvt_pk_bf16(o[0], o[1]); w.y = pg8::cvt_pk_bf16(o[2], o[3]); w.z = pg8::cvt_pk_bf16(o[4], o[5]); w.w = pg8::cvt_pk_bf16(o[6], o[7]);
          *(u32x4*)(base + (size_t)(row0 + ai * 128 + m * 16) * 256 + c0) = w;
        }
    }
  }
};

DN void phase_lora(const Params& p, int l) {
  pg8::Gemm g; g.A = (const bfr*)(p.ws + OFF_HO); g.Bt = (const bfr*)(p.ws + OFF_WLORA); g.M = MR; g.N = 1280; { int kk_ = 384; asm volatile("" : "+s"(kk_)); g.K = kk_; }
  MySched S; S.init(144, 5, gridDim.x, blockIdx.x, false); S.lora = true;
  { int nt_ = 2; asm volatile("" : "+s"(nt_)); g.ntov = nt_; }
  EpiLora E; E.RW = (bfr*)(p.ws + OFF_RWIN); E.w0 = p.in[oidx(11)] + (size_t)l * 512; E.a0 = p.in[oidx(13)] + (size_t)l * 512;
  pg8::gemm_phase<EpiLora, MySched, true, true>((LAS unsigned char*)dynlds, g, S, E);
}

DN void phase_g1(const Params& p) {
  pg8::Gemm g; g.A = (const bfr*)(p.ws + OFF_HO); g.Bt = (const bfr*)(p.ws + OFF_WIN); g.M = MR; g.N = NINP; g.K = DM;
  MySched S; S.init(144, 13, gridDim.x, blockIdx.x, false);
  EpiP E; E.P = (bfr*)(p.ws + OFF_P);
  pg8::gemm_phase<EpiP, MySched, true, true>((LAS unsigned char*)dynlds, g, S, E);
}

DN void phase_resid_gemm(const Params& p, int l, const bfr* A, const bfr* Bt, int K, int gi, bool src_input, bool skip_ctx) {
  pg8::Gemm g; g.A = A; g.Bt = Bt; g.M = MR; g.N = DM; g.K = K;
  MySched S; S.init(skip_ctx ? 128 : 144, 4, gridDim.x, blockIdx.x, skip_ctx);
  EpiResid E; E.xin = p.in[oidx(0)]; E.cin = p.in[oidx(2)]; E.xout = p.out; E.xc = (float*)(p.ws + OFF_XC);
  E.modl = (const float*)(p.ws + OFF_MOD) + (size_t)l * 17 * 6144; E.gi = gi; E.src_input = src_input;
  pg8::gemm_phase<EpiResid, MySched, true, true>((LAS unsigned char*)dynlds, g, S, E);
}

DN void phase_g3(const Params& p, int l, bool skip_ctx) {
  pg8::Gemm g; g.A = (const bfr*)(p.ws + OFF_HO); g.Bt = (const bfr*)(p.ws + OFF_WUP); g.M = MR; g.N = 2 * DFF; g.K = DM;
  MySched S; S.init(skip_ctx ? 128 : 144, 22, gridDim.x, blockIdx.x, skip_ctx);
  EpiFfn E; E.A2 = (bfr*)(p.ws + OFF_A2); E.EDGE = (float*)(p.ws + OFF_EDGE);
  E.cw = p.in[oidx(29)] + (size_t)l * 3 * DFF; E.cb = p.in[oidx(30)] + (size_t)l * DFF; E.bd = (LAS float*)(dynlds + LDS_BD_OFF);
  pg8::gemm_phase<EpiFfn, MySched, true, true>((LAS unsigned char*)dynlds, g, S, E);
}

DN void phase_fix(const Params& p, int l, bool skip_ctx) {
  bfr* A2 = (bfr*)(p.ws + OFF_A2);
  const float* EDGE = (const float*)(p.ws + OFF_EDGE);
  const float* cw = p.in[oidx(29)] + (size_t)l * 3 * DFF;
  const int gtid = VB() * 256 + otid(), gsz = NVB() * 256;
  const int total = 144 * 2 * DFF;
  for (int i = gtid; i < total; i += gsz) {
    int j = i % DFF, te = i / DFF;
    int tile = te >> 1, e = te & 1;
    int m0 = tile * 256;
    int t0 = m0 % TT;
    if (skip_ctx && t0 >= TL) continue;
    int rl = e ? 255 : 0;
    int t = t0 + rl;
    bool first = (t == 0) || (t == TL);
    bool last = (t == TL - 1) || (t == TT - 1);
    if (e == 0 && first) continue;
    if (e == 1 && last) continue;
    const float* me = EDGE + ((size_t)(tile * 2 + e) * DFF + j) * 3;
    const float* ot = e ? (EDGE + ((size_t)((tile + 1) * 2 + 0) * DFF + j) * 3) : (EDGE + ((size_t)((tile - 1) * 2 + 1) * DFF + j) * 3);
    float cwr = e ? cw[2 * DFF + j] : cw[j];
    float z = me[0] + cwr * ot[2];
    float a = z * __builtin_amdgcn_rcpf(1.f + __expf(-z)) * me[1];
    A2[(size_t)(m0 + rl) * DFF + j] = f2bf(a);
  }
}

DN void fix_own_tiles(const Params& p, int l, bool skip_ctx) {
  bfr* A2 = (bfr*)(p.ws + OFF_A2);
  const float* EDGE = (const float*)(p.ws + OFF_EDGE);
  const float* cw = p.in[oidx(29)] + (size_t)l * 3 * DFF;
  MySched S; S.init(skip_ctx ? 128 : 144, 4, gridDim.x, blockIdx.x, skip_ctx);
  int tid_ = threadIdx.x; asm volatile("" : "+v"(tid_));
  pg8::Unit u;
  for (int ui = 0; S.next(ui, u); ++ui) {
    const int tile = u.pm, m0 = tile * 256, t0 = m0 % TT;
    for (int i = tid_; i < 2 * DFF; i += 512) {
      const int e = (i >= DFF) ? 1 : 0, j = i - e * DFF;
      const int rl = e ? 255 : 0, t = t0 + rl;
      const bool first = (t == 0) || (t == TL), last = (t == TL - 1) || (t == TT - 1);
      if ((e == 0 && first) || (e == 1 && last)) continue;
      const float* me = EDGE + ((size_t)(tile * 2 + e) * DFF + j) * 3;
      const float* ot = e ? (EDGE + ((size_t)((tile + 1) * 2 + 0) * DFF + j) * 3) : (EDGE + ((size_t)((tile - 1) * 2 + 1) * DFF + j) * 3);
      const float cwr = e ? cw[2 * DFF + j] : cw[j];
      const float z = me[0] + cwr * ot[2];
      const float a = z * __builtin_amdgcn_rcpf(1.f + __expf(-z)) * me[1];
      A2[(size_t)(m0 + rl) * DFF + j] = f2bf(a);
    }
  }
  __syncthreads();
}

DI void unpack8(const u32x4 w, float (&o)[8]) {
  o[0] = __uint_as_float(w.x << 16); o[1] = __uint_as_float(w.x & 0xffff0000u);
  o[2] = __uint_as_float(w.y << 16); o[3] = __uint_as_float(w.y & 0xffff0000u);
  o[4] = __uint_as_float(w.z << 16); o[5] = __uint_as_float(w.z & 0xffff0000u);
  o[6] = __uint_as_float(w.w << 16); o[7] = __uint_as_float(w.w & 0xffff0000u);
}
DI void load8f(const float* p8, float (&o)[8]) {
  const f32x4v a = *(const f32x4v*)p8, b = *(const f32x4v*)(p8 + 4);
  o[0] = a.x; o[1] = a.y; o[2] = a.z; o[3] = a.w; o[4] = b.x; o[5] = b.y; o[6] = b.z; o[7] = b.w;
}
DI void shifted_load(const bfr* P, int m, int t, int col, const float* mu, float& out) {
  const bfr* row = P + (size_t)m * PW + col;
  float x = bf2f(row[0]);
  float xp = (t != 0 && t != TL) ? bf2f(row[-PW]) : 0.f;
  float xn = (t != TL - 1 && t != TT - 1) ? bf2f(row[PW]) : 0.f;
  out = x + mu[col] * (xp - x) + mu[1152 + col] * (xn - x);
}

DN void phase_prep(const Params& p, int l, char* smem) {
  bfr* P = (bfr*)(p.ws + OFF_P);
  bfr* AL = (bfr*)(p.ws + OFF_HO);
  const float* rope = (const float*)(p.ws + OFF_ROPE);
  const float* mu = p.in[oidx(10)] + (size_t)l * 2 * 1152;
  const int tid = otid(), lane = tid & 63, w = tid >> 6;
  for (int tile = VB(); tile < MR / 8; tile += NVB()) {
    int m0 = tile * 8;
    for (int i = tid; i < 8 * 48; i += 256) {
      const int tk = i / 48, g8 = i - tk * 48, cc = g8 * 8;
      const int m = m0 + tk, t = m % TT;
      const bfr* row = P + (size_t)m * PW + 768 + cc;
      const bool hp = (t != 0 && t != TL), hn = (t != TL - 1 && t != TT - 1);
      const u32x4 cur = *(const u32x4*)row;
      u32x4 prv = {0u, 0u, 0u, 0u}, nxt = {0u, 0u, 0u, 0u};
      if (hp) prv = *(const u32x4*)(row - PW);
      if (hn) nxt = *(const u32x4*)(row + PW);
      const f32x4v ma0 = *(const f32x4v*)(mu + 768 + cc), ma1 = *(const f32x4v*)(mu + 768 + cc + 4);
      const f32x4v mb0 = *(const f32x4v*)(mu + 1152 + 768 + cc), mb1 = *(const f32x4v*)(mu + 1152 + 768 + cc + 4);
      const float m0v[8] = {ma0.x, ma0.y, ma0.z, ma0.w, ma1.x, ma1.y, ma1.z, ma1.w};
      const float m1v[8] = {mb0.x, mb0.y, mb0.z, mb0.w, mb1.x, mb1.y, mb1.z, mb1.w};
      const unsigned cw_[4] = {cur.x, cur.y, cur.z, cur.w}, pw_[4] = {prv.x, prv.y, prv.z, prv.w}, nw_[4] = {nxt.x, nxt.y, nxt.z, nxt.w};
      float val[8];
#pragma unroll
      for (int e = 0; e < 8; ++e) {
        const float x = (e & 1) ? __uint_as_float(cw_[e >> 1] & 0xffff0000u) : __uint_as_float(cw_[e >> 1] << 16);
        const float xp = (e & 1) ? __uint_as_float(pw_[e >> 1] & 0xffff0000u) : __uint_as_float(pw_[e >> 1] << 16);
        const float xn = (e & 1) ? __uint_as_float(nw_[e >> 1] & 0xffff0000u) : __uint_as_float(nw_[e >> 1] << 16);
        const float xs = x + m0v[e] * (xp - x) + m1v[e] * (xn - x);
        val[e] = (cc < 128) ? (1.f - 2.f * __builtin_amdgcn_rcpf(1.f + __expf(2.f * xs))) : ((cc < 256) ? xs : __builtin_amdgcn_rcpf(1.f + __expf(-xs)));
      }
      u32x4 ow; ow.x = pack2(val[0], val[1]); ow.y = pack2(val[2], val[3]); ow.z = pack2(val[4], val[5]); ow.w = pack2(val[6], val[7]);
      *(u32x4*)(AL + (size_t)m * 384 + cc) = ow;
    }
    for (int i = tid; i < 8 * 112; i += 256) {
      const int tk = i / 112, gi = i - tk * 112;
      const int m = m0 + tk, t = m % TT;
      const bool da = gi < 64;
      const int gq = gi - 64;
      const bool isq = da ? (gi < 32) : (gq < 32);
      const int col = da ? (1152 + 8 * gi) : (isq ? (2720 + 8 * gq) : (2976 + 8 * (gq - 32)));
      const int dofs = da ? ((gi & 3) * 8) : ((gq & 7) * 8);
      bfr* ptr = P + (size_t)m * PW + col;
      float x[8], gs[8];
      unpack8(*(const u32x4*)ptr, x);
      load8f(da ? (p.in[oidx(21)] + (l * 2 + (isq ? 0 : 1)) * 32 + dofs) : (p.in[oidx(27)] + (l * 2 + (isq ? 0 : 1)) * 64 + dofs), gs);
      float ss = 0.f;
#pragma unroll
      for (int e = 0; e < 8; ++e) ss += x[e] * x[e];
      ss += dppf<0xB1>(ss); ss += dppf<0x4E>(ss);
      const float ss8 = ss + dppf<0x141>(ss);
      const float rstd = da ? rsqrtf(ss * (1.f / 32.f) + 1e-6f) : rsqrtf(ss8 * (1.f / 64.f) + 1e-6f);
      float y[8];
#pragma unroll
      for (int e = 0; e < 8; ++e) y[e] = x[e] * rstd * gs[e];
      float yp2[8], yp4[8];
#pragma unroll
      for (int e = 0; e < 8; ++e) { yp2[e] = __shfl_xor(y[e], 2); yp4[e] = __shfl_xor(y[e], 4); }
      if (t < TL) {
        const int idx0 = da ? ((gi & 1) * 8) : ((gq & 3) * 8);
        const bool first = da ? ((gi & 2) == 0) : ((gq & 4) == 0);
        float cs[8], sn[8];
        load8f(rope + t * 96 + (da ? 0 : 32) + idx0, cs);
        load8f(rope + t * 96 + (da ? 16 : 64) + idx0, sn);
#pragma unroll
        for (int e = 0; e < 8; ++e) {
          const float yp = da ? yp2[e] : yp4[e];
          y[e] = first ? (y[e] * cs[e] - yp * sn[e]) : (y[e] * cs[e] + yp * sn[e]);
        }
      }
      const float qs = isq ? (da ? 0.25503486f : 0.18033688f) : 1.f;
      u32x4 ow; ow.x = pack2(y[0] * qs, y[1] * qs); ow.y = pack2(y[2] * qs, y[3] * qs); ow.z = pack2(y[4] * qs, y[5] * qs); ow.w = pack2(y[6] * qs, y[7] * qs);
      *(u32x4*)ptr = ow;
    }
  }
}

template <int D>
DI void attn_pass(const bfr* __restrict__ P, int b, int tq_wave, int qcol, int kcol, int vcol, int key0, int nkt, char* smem, f32x16 (&o)[2]) {
  constexpr int KS = D / 16, KP = D + 8, NKR = D / 32, CPR = D / 8;
  bfr* sbase = (bfr*)dynlds;
  const int tid = otid(), lane = tid & 63, r = lane & 31, h = lane >> 5;
  const int gt = vhalf() * 256 + tid;
  bf16x8 qf[KS];
  {
    const bfr* qrow = P + (size_t)(b * TT + tq_wave + r) * PW + qcol;
#pragma unroll
    for (int ks = 0; ks < KS; ++ks) qf[ks] = *(const bf16x8*)(qrow + ks * 16 + h * 8);
  }
  f32x16 accO[2];
#pragma unroll
  for (int i = 0; i < 16; ++i) { accO[0][i] = 0.f; accO[1][i] = 0.f; }
  float mrun = -1e30f, lsum = 0.f;
  u32x4 kreg[1], vreg[1];
  const bfr* Pb = P + (size_t)(b * TT + key0) * PW;
  static_assert(D == 64, "block-mode attention pass stages one 16-byte K chunk per thread");
  { int c = gt, row = c >> 3, kc = c & 7; kreg[0] = *(const u32x4*)(Pb + (size_t)row * PW + kcol + kc * 8); vreg[0] = *(const u32x4*)(Pb + (size_t)row * PW + vcol + kc * 8); }
  for (int kt = 0; kt < nkt; ++kt) {
    bfr* sK = sbase + (kt & 1) * 9216;
    bfr* sV = sK + 64 * 72;
    { int c = gt, row = c >> 3, kc = c & 7; *(u32x4*)(sK + row * KP + kc * 8) = kreg[0]; }
    for (int i = 0; i < 1; ++i) {
      int c = gt, row = c >> 3, kc = c & 7;
      unsigned wds[4] = {vreg[i].x, vreg[i].y, vreg[i].z, vreg[i].w};
#pragma unroll
      for (int e = 0; e < 4; ++e) {
        sV[(kc * 8 + 2 * e) * 72 + (row ^ (kc << 3))] = (bfr)(wds[e] & 0xffffu);
        sV[(kc * 8 + 2 * e + 1) * 72 + (row ^ (kc << 3))] = (bfr)(wds[e] >> 16);
      }
    }
    __syncthreads();
    if (kt + 1 < nkt) {
      const bfr* Pn = Pb + (size_t)(kt + 1) * 64 * PW;
      { int c = gt, row = c >> 3, kc = c & 7; kreg[0] = *(const u32x4*)(Pn + (size_t)row * PW + kcol + kc * 8); vreg[0] = *(const u32x4*)(Pn + (size_t)row * PW + vcol + kc * 8); }
    }
    f32x16 s[2];
#pragma unroll
    for (int t2 = 0; t2 < 2; ++t2) {
#pragma unroll
      for (int i = 0; i < 16; ++i) s[t2][i] = 0.f;
#pragma unroll
      for (int ks = 0; ks < KS; ++ks) {
        bf16x8 a = *(const bf16x8*)(sK + (t2 * 32 + r) * KP + ks * 16 + h * 8);
        s[t2] = MFMA32(a, qf[ks], s[t2]);
      }
    }
    float mx = s[0][0];
#pragma unroll
    for (int i = 0; i < 16; ++i) { mx = fmaxf(mx, s[0][i]); mx = fmaxf(mx, s[1][i]); }
    mx = fmaxf(mx, __shfl_xor(mx, 32));
    float mnew = fmaxf(mrun, mx);
    float alpha = __builtin_amdgcn_exp2f(mrun - mnew);
    mrun = mnew;
    float ps = 0.f;
#pragma unroll
    for (int i = 0; i < 16; ++i) {
      s[0][i] = __builtin_amdgcn_exp2f(s[0][i] - mnew); ps += s[0][i];
      s[1][i] = __builtin_amdgcn_exp2f(s[1][i] - mnew); ps += s[1][i];
    }
    lsum = lsum * alpha + ps;
#pragma unroll
    for (int i = 0; i < 16; ++i) { accO[0][i] *= alpha; accO[1][i] *= alpha; }
#pragma unroll
    for (int t2 = 0; t2 < 2; ++t2)
#pragma unroll
      for (int j = 0; j < 2; ++j) {
        unsigned pk[4];
#pragma unroll
        for (int e = 0; e < 4; ++e) pk[e] = pack2(s[t2][8 * j + 2 * e], s[t2][8 * j + 2 * e + 1]);
        u32x4 pku = {pk[0], pk[1], pk[2], pk[3]};
        bf16x8 pf = __builtin_bit_cast(bf16x8, pku);
#pragma unroll
        for (int dt = 0; dt < 2; ++dt) {
          const int vsw = (((dt * 32 + r) >> 3) & 7) << 3;
          const bfr* vrow = sV + (dt * 32 + r) * 72;
          s16x4 lo = *(const s16x4*)(vrow + ((t2 * 32 + 16 * j + 4 * h) ^ vsw));
          s16x4 hi = *(const s16x4*)(vrow + ((t2 * 32 + 16 * j + 4 * h + 8) ^ vsw));
          bf16x8 vf = __builtin_shufflevector(lo, hi, 0, 1, 2, 3, 4, 5, 6, 7);
          accO[dt] = MFMA32(vf, pf, accO[dt]);
        }
      }
  }
  lsum += __shfl_xor(lsum, 32);
  float inv = 1.f / lsum;
#pragma unroll
  for (int i = 0; i < 16; ++i) { o[0][i] = accO[0][i] * inv; o[1][i] = accO[1][i] * inv; }
}

DI void attn_pass_da(const bfr* __restrict__ P, int b, int tq_wave, int qcol, int kcol, int vcol, int key0, int nkt, char* smem, f32x16 (&o0)[2], f32x16 (&o1)[2]) {
  constexpr int KP = 72;
  bfr* sbase = (bfr*)dynlds;
  const int tid = otid(), lane = tid & 63, r = lane & 31, h = lane >> 5;
  const int gt = vhalf() * 256 + tid;
  bf16x8 qf[4];
  {
    const bfr* qrow = P + (size_t)(b * TT + tq_wave + r) * PW + qcol;
#pragma unroll
    for (int ks = 0; ks < 4; ++ks) qf[ks] = *(const bf16x8*)(qrow + ks * 16 + h * 8);
  }
  f32x16 acc0[2], acc1[2];
#pragma unroll
  for (int i = 0; i < 16; ++i) { acc0[0][i] = 0.f; acc0[1][i] = 0.f; acc1[0][i] = 0.f; acc1[1][i] = 0.f; }
  float m0 = -1e30f, l0 = 0.f, m1 = -1e30f, l1 = 0.f;
  u32x4 kreg[1], vreg[1];
  const bfr* Pb = P + (size_t)(b * TT + key0) * PW;
  { int c = gt, row = c >> 3, kc = c & 7; kreg[0] = *(const u32x4*)(Pb + (size_t)row * PW + kcol + kc * 8); vreg[0] = *(const u32x4*)(Pb + (size_t)row * PW + vcol + kc * 8); }
  for (int kt = 0; kt < nkt; ++kt) {
    bfr* sK = sbase + (kt & 1) * 9216;
    bfr* sV = sK + 64 * 72;
    { int c = gt, row = c >> 3, kc = c & 7; *(u32x4*)(sK + row * KP + kc * 8) = kreg[0]; }
    for (int i = 0; i < 1; ++i) {
      int c = gt, row = c >> 3, kc = c & 7;
      unsigned wds[4] = {vreg[i].x, vreg[i].y, vreg[i].z, vreg[i].w};
#pragma unroll
      for (int e = 0; e < 4; ++e) {
        sV[(kc * 8 + 2 * e) * 72 + (row ^ (kc << 3))] = (bfr)(wds[e] & 0xffffu);
        sV[(kc * 8 + 2 * e + 1) * 72 + (row ^ (kc << 3))] = (bfr)(wds[e] >> 16);
      }
    }
    __syncthreads();
    if (kt + 1 < nkt) {
      const bfr* Pn = Pb + (size_t)(kt + 1) * 64 * PW;
      { int c = gt, row = c >> 3, kc = c & 7; kreg[0] = *(const u32x4*)(Pn + (size_t)row * PW + kcol + kc * 8); vreg[0] = *(const u32x4*)(Pn + (size_t)row * PW + vcol + kc * 8); }
    }
    f32x16 s0[2], s1[2];
#pragma unroll
    for (int t2 = 0; t2 < 2; ++t2) {
#pragma unroll
      for (int i = 0; i < 16; ++i) { s0[t2][i] = 0.f; s1[t2][i] = 0.f; }
#pragma unroll
      for (int ks = 0; ks < 2; ++ks) {
        bf16x8 a0 = *(const bf16x8*)(sK + (t2 * 32 + r) * KP + ks * 16 + h * 8);
        bf16x8 a1 = *(const bf16x8*)(sK + (t2 * 32 + r) * KP + 32 + ks * 16 + h * 8);
        s0[t2] = MFMA32(a0, qf[ks], s0[t2]);
        s1[t2] = MFMA32(a1, qf[2 + ks], s1[t2]);
      }
    }
    float mx0 = s0[0][0], mx1 = s1[0][0];
#pragma unroll
    for (int i = 0; i < 16; ++i) { mx0 = fmaxf(mx0, fmaxf(s0[0][i], s0[1][i])); mx1 = fmaxf(mx1, fmaxf(s1[0][i], s1[1][i])); }
    mx0 = fmaxf(mx0, __shfl_xor(mx0, 32)); mx1 = fmaxf(mx1, __shfl_xor(mx1, 32));
    const float mn0 = fmaxf(m0, mx0), mn1 = fmaxf(m1, mx1);
    const float al0 = __builtin_amdgcn_exp2f(m0 - mn0), al1 = __builtin_amdgcn_exp2f(m1 - mn1);
    m0 = mn0; m1 = mn1;
    float ps0 = 0.f, ps1 = 0.f;
#pragma unroll
    for (int i = 0; i < 16; ++i) {
      s0[0][i] = __builtin_amdgcn_exp2f(s0[0][i] - mn0); ps0 += s0[0][i];
      s0[1][i] = __builtin_amdgcn_exp2f(s0[1][i] - mn0); ps0 += s0[1][i];
      s1[0][i] = __builtin_amdgcn_exp2f(s1[0][i] - mn1); ps1 += s1[0][i];
      s1[1][i] = __builtin_amdgcn_exp2f(s1[1][i] - mn1); ps1 += s1[1][i];
    }
    l0 = l0 * al0 + ps0; l1 = l1 * al1 + ps1;
#pragma unroll
    for (int i = 0; i < 16; ++i) { acc0[0][i] *= al0; acc0[1][i] *= al0; acc1[0][i] *= al1; acc1[1][i] *= al1; }
#pragma unroll
    for (int t2 = 0; t2 < 2; ++t2)
#pragma unroll
      for (int j = 0; j < 2; ++j) {
        u32x4 pk0, pk1;
        pk0.x = pack2(s0[t2][8 * j + 0], s0[t2][8 * j + 1]); pk0.y = pack2(s0[t2][8 * j + 2], s0[t2][8 * j + 3]);
        pk0.z = pack2(s0[t2][8 * j + 4], s0[t2][8 * j + 5]); pk0.w = pack2(s0[t2][8 * j + 6], s0[t2][8 * j + 7]);
        pk1.x = pack2(s1[t2][8 * j + 0], s1[t2][8 * j + 1]); pk1.y = pack2(s1[t2][8 * j + 2], s1[t2][8 * j + 3]);
        pk1.z = pack2(s1[t2][8 * j + 4], s1[t2][8 * j + 5]); pk1.w = pack2(s1[t2][8 * j + 6], s1[t2][8 * j + 7]);
        const bf16x8 pf0 = __builtin_bit_cast(bf16x8, pk0), pf1 = __builtin_bit_cast(bf16x8, pk1);
#pragma unroll
        for (int dt = 0; dt < 2; ++dt) {
          const int vsw = (((dt * 32 + r) >> 3) & 7) << 3;
          const bfr* vrow = sV + (dt * 32 + r) * 72;
          s16x4 lo = *(const s16x4*)(vrow + ((t2 * 32 + 16 * j + 4 * h) ^ vsw));
          s16x4 hi = *(const s16x4*)(vrow + ((t2 * 32 + 16 * j + 4 * h + 8) ^ vsw));
          bf16x8 vf = __builtin_shufflevector(lo, hi, 0, 1, 2, 3, 4, 5, 6, 7);
          acc0[dt] = MFMA32(vf, pf0, acc0[dt]);
          acc1[dt] = MFMA32(vf, pf1, acc1[dt]);
        }
      }
  }
  l0 += __shfl_xor(l0, 32); l1 += __shfl_xor(l1, 32);
  const float i0 = 1.f / l0, i1 = 1.f / l1;
#pragma unroll
  for (int i = 0; i < 16; ++i) { o0[0][i] = acc0[0][i] * i0; o0[1][i] = acc0[1][i] * i0; o1[0][i] = acc1[0][i] * i1; o1[1][i] = acc1[1][i] * i1; }
}

DI void store_o(bfr* O, int m, int colbase, int h, const f32x16 (&o)[2]) {
#pragma unroll
  for (int dt = 0; dt < 2; ++dt)
#pragma unroll
    for (int g4 = 0; g4 < 4; ++g4) {
      int dv = dt * 32 + 8 * g4 + 4 * h;
      uint2 pk; pk.x = pack2(o[dt][4 * g4], o[dt][4 * g4 + 1]); pk.y = pack2(o[dt][4 * g4 + 2], o[dt][4 * g4 + 3]);
      *(uint2*)(O + (size_t)m * DM + colbase + dv) = pk;
    }
}

DN void da_item(const Params& p, int l, int b, int hd, int tq0, int key0, int nkt, char* smem) {
  const bfr* P = (const bfr*)(p.ws + OFF_P);
  bfr* O = (bfr*)(p.ws + OFF_HO);
  const int tid = otid(), lane = tid & 63, w = tid >> 6, r = lane & 31, h = lane >> 5;
  const float* lv = p.in[oidx(22)] + l * 128;
  float d01 = (lane < 32) ? lv[lane] * lv[32 + lane] : 0.f;
  float d23 = (lane < 32) ? lv[64 + lane] * lv[96 + lane] : 0.f;
  d01 = wave_sum(d01); d23 = wave_sum(d23);
  float lam_init = 0.8f - 0.6f * expf(-0.3f * (float)l);
  float lam = expf(d01) - expf(d23) + lam_init;
  f32x16 o0[2], o1[2];
  int tqw = tq0 + vhalf() * 128 + w * 32;
  attn_pass_da(P, b, tqw, 1152 + hd * 64, 1408 + hd * 64, 1664 + hd * 64, key0, nkt, smem, o0, o1);
  float ss = 0.f;
#pragma unroll
  for (int dt = 0; dt < 2; ++dt)
#pragma unroll
    for (int i = 0; i < 16; ++i) { float v = o0[dt][i] - lam * o1[dt][i]; o0[dt][i] = v; ss += v * v; }
  ss += __shfl_xor(ss, 32);
  float rstd = rsqrtf(ss * (1.f / 64.f) + 1e-6f) * (1.f - lam_init);
  const float* sg = p.in[oidx(23)] + l * 64;
#pragma unroll
  for (int dt = 0; dt < 2; ++dt)
#pragma unroll
    for (int i = 0; i < 16; ++i) { int dv = dt * 32 + 8 * (i >> 2) + 4 * h + (i & 3); o0[dt][i] = o0[dt][i] * rstd * sg[dv]; }
  store_o(O, b * TT + tqw + r, 256 + hd * 64, h, o0);
}

DN void gqa_item(const Params& p, int b, int hq, int tq0, int key0, int nkt, char* smem) {
  const bfr* P = (const bfr*)(p.ws + OFF_P);
  bfr* O = (bfr*)(p.ws + OFF_HO);
  const int tid = otid(), lane = tid & 63, w = tid >> 6, r = lane & 31, h = lane >> 5;
  f32x16 o[2];
  int tqw = tq0 + vhalf() * 128 + w * 32;
  attn_pass<64>(P, b, tqw, 2720 + hq * 64, 2976 + (hq >> 1) * 64, 3104 + (hq >> 1) * 64, key0, nkt, smem, o);
  store_o(O, b * TT + tqw + r, 768 + hq * 64, h, o);
}

struct RwRegs { bfr lr[4][3], lk[4][3], lv[4][3], le[4], la[4]; };

DN void rw_scan_item(const Params& p, int l, int item, bool need_ctx, int mode) {
  const int dir = item & 1, hh = (item >> 1) & 3, b = item >> 3;
  const int half = vhalf();
  float* lbase = (float*)dynlds;
  const bfr* P = (const bfr*)(p.ws + OFF_P);
  const bfr* RWE = (const bfr*)(p.ws + OFF_RWIN) + (size_t)dir * MR * 256;
  const bfr* RWA = (const bfr*)(p.ws + OFF_RWIN) + (size_t)(2 + dir) * MR * 256;
  bfr* Y = (bfr*)(p.ws + OFF_RWY) + (size_t)dir * MR * 256;
  const int tid = otid();
  const int nchunks = TT / 16;
  auto tokof = [&](int tau) -> int {
    if (dir == 0) return (tau < TC) ? (TL + tau) : (tau - TC);
    return (tau < TC) ? (TL + TC - 1 - tau) : (TL - 1 - (tau - TC));
  };
  __syncthreads();
  if (half == 1) {
    const int ch = tid & 63, c256 = hh * 64 + ch;
    const float* mu = p.in[oidx(10)] + (size_t)l * 2 * 1152;
    const float mr0 = mu[c256], mr1 = mu[1152 + c256], mk0 = mu[256 + c256], mk1 = mu[1152 + 256 + c256], mv0 = mu[512 + c256], mv1 = mu[1152 + 512 + c256];
    const float kkw = p.in[oidx(16)][l * 256 + c256], kaw = p.in[oidx(17)][l * 256 + c256];
    auto gload = [&](RwRegs& R, int c) {
#pragma unroll
      for (int i = 0; i < 4; ++i) {
        int s = (tid >> 6) + 4 * i;
        int t = tokof(c * 16 + s);
        size_t m = (size_t)b * TT + t;
        bool hp = (t != 0 && t != TL), hn = (t != TL - 1 && t != TT - 1);
        const bfr* row = P + m * PW + c256;
        R.lr[i][1] = row[0]; R.lk[i][1] = row[256]; R.lv[i][1] = row[512];
        R.lr[i][0] = hp ? row[-PW] : (bfr)0; R.lk[i][0] = hp ? row[256 - PW] : (bfr)0; R.lv[i][0] = hp ? row[512 - PW] : (bfr)0;
        R.lr[i][2] = hn ? row[PW] : (bfr)0; R.lk[i][2] = hn ? row[256 + PW] : (bfr)0; R.lv[i][2] = hn ? row[512 + PW] : (bfr)0;
        R.le[i] = RWE[m * 256 + c256]; R.la[i] = RWA[m * 256 + c256];
      }
    };
    auto prep = [&](const RwRegs& R, int c) {
      float* vec = lbase + (c & 1) * 7168;
      float* vvv = vec + 16 * 5 * 64;
#pragma unroll
      for (int i = 0; i < 4; ++i) {
        int s = (tid >> 6) + 4 * i;
        float r0 = bf2f(R.lr[i][1]), k0 = bf2f(R.lk[i][1]), v0 = bf2f(R.lv[i][1]);
        float rr = r0 + mr0 * (bf2f(R.lr[i][0]) - r0) + mr1 * (bf2f(R.lr[i][2]) - r0);
        float kx = k0 + mk0 * (bf2f(R.lk[i][0]) - k0) + mk1 * (bf2f(R.lk[i][2]) - k0);
        float vx = v0 + mv0 * (bf2f(R.lv[i][0]) - v0) + mv1 * (bf2f(R.lv[i][2]) - v0);
        float kkp = kx * kkw;
        float ss = wave_sum(kkp * kkp);
        float kk = kkp * rsqrtf(ss + 1e-12f);
        float a = bf2f(R.la[i]);
        float wdec = __expf(-bf2f(R.le[i]));
        float kd = kx * (1.f + (a - 1.f) * kaw);
        float* vs = vec + s * 320;
        vs[ch] = wdec; vs[64 + ch] = kd; vs[128 + ch] = -kk; vs[192 + ch] = kk * a; vs[256 + ch] = rr;
        vvv[s * 64 + ch] = vx;
      }
    };
    auto yout = [&](int cprev) {
      const float* yb = lbase + (cprev & 1) * 7168 + 16 * 5 * 64 + 16 * 64;
#pragma unroll
      for (int i = 0; i < 4; ++i) {
        int idx = tid + 256 * i;
        int s = idx >> 6, rr = idx & 63;
        int t = tokof(cprev * 16 + s);
        if (t < TL || need_ctx) Y[((size_t)b * TT + t) * 256 + hh * 64 + rr] = f2bf(yb[s * 64 + rr]);
      }
    };
    RwRegs RA, RB;
    gload(RA, 0);
    gload(RB, 1);
    prep(RA, 0);
    if (mode != 2) gload(RA, 2);
    __syncthreads();
#pragma unroll 1
    for (int c = 0; c < nchunks; c += 2) {
      prep(RB, c + 1);
      if (c + 3 < nchunks && mode != 2) gload(RB, c + 3);
      if (c > 0 && mode == 0) yout(c - 1);
      __syncthreads();
      if (c + 2 < nchunks) prep(RA, c + 2);
      if (c + 4 < nchunks && mode != 2) gload(RA, c + 4);
      if (mode == 0) yout(c);
      __syncthreads();
    }
    if (mode == 0) yout(nchunks - 1);
  } else {
    const int rq = tid >> 4, j16 = tid & 15;
    f32x2 S[4][2];
#pragma unroll
    for (int k = 0; k < 4; ++k) { S[k][0] = (f32x2){0.f, 0.f}; S[k][1] = (f32x2){0.f, 0.f}; }
    __syncthreads();
#pragma unroll 1
    for (int c = 0; c < nchunks; ++c) {
      const float* vec = lbase + (c & 1) * 7168;
      const float* vvv = vec + 16 * 5 * 64;
      float* ybuf = lbase + (c & 1) * 7168 + 16 * 5 * 64 + 16 * 64;
      if (mode != 1) {
        float ykeep[4] = {0.f, 0.f, 0.f, 0.f};
#pragma unroll
        for (int hb = 0; hb < 2; ++hb) {
          float yp[4][8];
#pragma unroll
          for (int s8 = 0; s8 < 8; ++s8) {
            const int s = hb * 8 + s8;
            const float* vs = vec + s * 320 + j16 * 4;
            const f32x4v w0 = *(const f32x4v*)(vs);
            const f32x4v d0 = *(const f32x4v*)(vs + 64);
            const f32x4v a0 = *(const f32x4v*)(vs + 128);
            const f32x4v b0 = *(const f32x4v*)(vs + 192);
            const f32x4v q0 = *(const f32x4v*)(vs + 256);
            float sa[4], vi[4];
#pragma unroll
            for (int k = 0; k < 4; ++k) {
              vi[k] = vvv[s * 64 + rq + 16 * k];
              f32x2 t = S[k][0] * a0.xy;
              t = S[k][1] * a0.zw + t;
              sa[k] = t.x + t.y;
            }
#pragma unroll
            for (int k = 0; k < 4; ++k) sa[k] += dppf<0xB1>(sa[k]);
#pragma unroll
            for (int k = 0; k < 4; ++k) sa[k] += dppf<0x4E>(sa[k]);
#pragma unroll
            for (int k = 0; k < 4; ++k) sa[k] += dppf<0x141>(sa[k]);
#pragma unroll
            for (int k = 0; k < 4; ++k) sa[k] += dppf<0x140>(sa[k]);
#pragma unroll
            for (int k = 0; k < 4; ++k) {
              const f32x2 s2 = (f32x2){sa[k], sa[k]}, v2 = (f32x2){vi[k], vi[k]};
              S[k][0] = S[k][0] * w0.xy + (s2 * b0.xy + v2 * d0.xy);
              S[k][1] = S[k][1] * w0.zw + (s2 * b0.zw + v2 * d0.zw);
              f32x2 y2 = S[k][0] * q0.xy;
              y2 = S[k][1] * q0.zw + y2;
              yp[k][s8] = y2.x + y2.y;
            }
          }
#pragma unroll
          for (int s8 = 0; s8 < 8; ++s8)
#pragma unroll
            for (int k = 0; k < 4; ++k) {
              float ra = yp[k][s8];
              ra += dppf<0xB1>(ra); ra += dppf<0x4E>(ra); ra += dppf<0x141>(ra); ra += dppf<0x140>(ra);
              ykeep[k] = ((hb * 8 + s8) == j16) ? ra : ykeep[k];
            }
        }
#pragma unroll
        for (int k = 0; k < 4; ++k) ybuf[j16 * 64 + rq + 16 * k] = ykeep[k];
      }
      __syncthreads();
    }
  }
  __syncthreads();
}

DI float logsigf_(float x) { return fminf(x, 0.f) - __logf(1.f + __expf(-fabsf(x))); }

DN void gla_state_item(const Params& p, int l, int item, char* smem) {
  const int dir = item & 1, hh = (item >> 1) & 3, b = item >> 3;
  float* kk_ = (float*)smem;
  float* vv = kk_ + 64 * 33;
  float* bb = vv + 64 * 64;
  float* gg = bb + 64 * 33;
  float* sbend = gg + 64 * 16;
  float* segs = sbend + 32;
  const bfr* P = (const bfr*)(p.ws + OFF_P);
  float* GS = (float*)(p.ws + OFF_GS);
  const int tid = otid();
  const int d = tid >> 3, e0 = (tid & 7) * 8;
  float S[8];
#pragma unroll
  for (int e = 0; e < 8; ++e) S[e] = 0.f;
  const int dl = tid & 31, lgrp = tid >> 5;
  float a2c[16];
#pragma unroll
  for (int q = 0; q < 16; ++q) a2c[q] = p.in[oidx(24)][((size_t)(l * 2 + dir) * 16 + q) * 128 + hh * 32 + dl];
  const float abv = p.in[oidx(25)][(l * 2 + dir) * 128 + hh * 32 + dl];
  for (int c = 0; c < 36; ++c) {
    int cs = (dir == 0) ? (c < 4 ? 32 + c : c - 4) : (c < 4 ? 35 - c : 35 - c);
    size_t m0 = (size_t)b * TT + cs * 64;
    vsync();
    {
      float t8[8];
      { const int li = tid >> 2, d8 = (tid & 3) * 8; unpack8(*(const u32x4*)(P + (m0 + li) * PW + 2048 + hh * 32 + d8), t8);
#pragma unroll
        for (int e = 0; e < 8; ++e) kk_[li * 33 + d8 + e] = t8[e]; }
#pragma unroll
      for (int i = 0; i < 2; ++i) { const int c = tid + 256 * i, li = c >> 3, e8 = (c & 7) * 8; unpack8(*(const u32x4*)(P + (m0 + li) * PW + 2176 + hh * 64 + e8), t8);
        *(f32x4v*)(vv + li * 64 + e8) = (f32x4v){t8[0], t8[1], t8[2], t8[3]}; *(f32x4v*)(vv + li * 64 + e8 + 4) = (f32x4v){t8[4], t8[5], t8[6], t8[7]}; }
      if (tid < 128) { const int li = tid >> 1, q8 = (tid & 1) * 8; unpack8(*(const u32x4*)(P + (m0 + li) * PW + 2432 + dir * 16 + q8), t8);
        *(f32x4v*)(gg + li * 16 + q8) = (f32x4v){t8[0], t8[1], t8[2], t8[3]}; *(f32x4v*)(gg + li * 16 + q8 + 4) = (f32x4v){t8[4], t8[5], t8[6], t8[7]}; }
    }
    vsync();
    {
      float lgv[8];
#pragma unroll
      for (int li = 0; li < 8; ++li) {
        int lt = lgrp * 8 + li;
        float x = abv;
#pragma unroll
        for (int q = 0; q < 16; ++q) x += gg[lt * 16 + q] * a2c[q];
        lgv[li] = logsigf_(x) * (1.f / 16.f);
      }
      if (dir == 0) {
#pragma unroll
        for (int li = 1; li < 8; ++li) lgv[li] += lgv[li - 1];
        segs[lgrp * 32 + dl] = lgv[7];
      } else {
#pragma unroll
        for (int li = 6; li >= 0; --li) lgv[li] += lgv[li + 1];
        segs[lgrp * 32 + dl] = lgv[0];
      }
      vsync_l();
      float off = 0.f, tot = 0.f;
#pragma unroll
      for (int sg = 0; sg < 8; ++sg) {
        const float sv = segs[sg * 32 + dl];
        tot += sv;
        if ((dir == 0) ? (sg < lgrp) : (sg > lgrp)) off += sv;
      }
#pragma unroll
      for (int li = 0; li < 8; ++li) bb[(lgrp * 8 + li) * 33 + dl] = lgv[li] + off;
      if (lgrp == 0) sbend[dl] = tot;
    }
    vsync_l();
    for (int i = tid; i < 2048; i += 256) { int li = i >> 5, dd = i & 31; kk_[li * 33 + dd] *= __expf(sbend[dd] - bb[li * 33 + dd]); }
    {
      float* dst = GS + ((((size_t)b * 36 + cs) * 4 + hh) * 2 + dir) * 2048 + d * 64 + e0;
      *(float4*)dst = make_float4(S[0], S[1], S[2], S[3]);
      *(float4*)(dst + 4) = make_float4(S[4], S[5], S[6], S[7]);
    }
    vsync();
    float dec = __expf(sbend[d]);
#pragma unroll
    for (int e = 0; e < 8; ++e) S[e] *= dec;
    for (int lt = 0; lt < 64; ++lt) {
      float kv = kk_[lt * 33 + d];
      float4 v0 = *(const float4*)(vv + lt * 64 + e0), v1 = *(const float4*)(vv + lt * 64 + e0 + 4);
      S[0] += kv * v0.x; S[1] += kv * v0.y; S[2] += kv * v0.z; S[3] += kv * v0.w;
      S[4] += kv * v1.x; S[5] += kv * v1.y; S[6] += kv * v1.z; S[7] += kv * v1.w;
    }
  }
}

DN void gla_finish_item(const Params& p, int l, int b, int cs, int hh, char* smem) {
  bfr* QiB = (bfr*)smem;
  bfr* KiB = QiB + 64 * 40;
  bfr* StB = KiB + 64 * 40;
  bfr* VtB = StB + 64 * 40;
  float* bb = (float*)(VtB + 64 * 72);
  float* gg = bb + 64 * 33;
  float* segs = gg + 64 * 16;
  float* ssq = segs + 256;
  const bfr* P = (const bfr*)(p.ws + OFF_P);
  const float* GS = (const float*)(p.ws + OFF_GS);
  bfr* O = (bfr*)(p.ws + OFF_HO);
  const int tid = otid(), lane = tid & 63, w = tid >> 6, r = lane & 31, h = lane >> 5;
  const int et = w >> 1, it = w & 1;
  const size_t m0 = (size_t)b * TT + cs * 64;
  const int dl = tid & 31, lgrp = tid >> 5;
  const int li4 = tid >> 2, d8 = (tid & 3) * 8;
  f32x16 accO;
#pragma unroll
  for (int i = 0; i < 16; ++i) accO[i] = 0.f;
  vsync();
  {
#pragma unroll
    for (int i = 0; i < 2; ++i) {
      const int c = tid + 256 * i, row = c >> 3, kc = c & 7;
      const u32x4 v = *(const u32x4*)(P + (m0 + row) * PW + 2176 + hh * 64 + kc * 8);
      const unsigned wds[4] = {v.x, v.y, v.z, v.w};
#pragma unroll
      for (int e = 0; e < 4; ++e) {
        VtB[(kc * 8 + 2 * e) * 72 + (row ^ (kc << 3))] = (bfr)(wds[e] & 0xffffu);
        VtB[(kc * 8 + 2 * e + 1) * 72 + (row ^ (kc << 3))] = (bfr)(wds[e] >> 16);
      }
    }
  }
#pragma unroll 1
  for (int dir = 0; dir < 2; ++dir) {
    vsync_l();
    float q8[8], k8[8];
    unpack8(*(const u32x4*)(P + (m0 + li4) * PW + 1920 + hh * 32 + d8), q8);
    unpack8(*(const u32x4*)(P + (m0 + li4) * PW + 2048 + hh * 32 + d8), k8);
    if (tid < 128) {
      float t8[8];
      const int lg_ = tid >> 1, qq = (tid & 1) * 8;
      unpack8(*(const u32x4*)(P + (m0 + lg_) * PW + 2432 + dir * 16 + qq), t8);
      *(f32x4v*)(gg + lg_ * 16 + qq) = (f32x4v){t8[0], t8[1], t8[2], t8[3]}; *(f32x4v*)(gg + lg_ * 16 + qq + 4) = (f32x4v){t8[4], t8[5], t8[6], t8[7]};
    }
    {
      const float* Sg = GS + ((((size_t)b * 36 + cs) * 4 + hh) * 2 + dir) * 2048;
      const int d = tid >> 3, e8 = (tid & 7) * 8;
      float s8[8];
      load8f(Sg + d * 64 + e8, s8);
#pragma unroll
      for (int e = 0; e < 8; ++e) StB[(e8 + e) * 40 + d] = f2bf(s8[e]);
    }
    vsync_l();
    {
      float a2c[16];
#pragma unroll
      for (int q = 0; q < 16; ++q) a2c[q] = p.in[oidx(24)][((size_t)(l * 2 + dir) * 16 + q) * 128 + hh * 32 + dl];
      const float abv = p.in[oidx(25)][(l * 2 + dir) * 128 + hh * 32 + dl];
      float lgv[8];
#pragma unroll
      for (int li = 0; li < 8; ++li) {
        int lt = lgrp * 8 + li;
        float x = abv;
#pragma unroll
        for (int q = 0; q < 16; ++q) x += gg[lt * 16 + q] * a2c[q];
        lgv[li] = logsigf_(x) * (1.f / 16.f);
      }
      if (dir == 0) {
#pragma unroll
        for (int li = 1; li < 8; ++li) lgv[li] += lgv[li - 1];
        segs[lgrp * 32 + dl] = lgv[7];
      } else {
#pragma unroll
        for (int li = 6; li >= 0; --li) lgv[li] += lgv[li + 1];
        segs[lgrp * 32 + dl] = lgv[0];
      }
      vsync_l();
      float off = 0.f;
#pragma unroll
      for (int sg = 0; sg < 8; ++sg) {
        const float sv = segs[sg * 32 + dl];
        if ((dir == 0) ? (sg < lgrp) : (sg > lgrp)) off += sv;
      }
#pragma unroll
      for (int li = 0; li < 8; ++li) bb[(lgrp * 8 + li) * 33 + dl] = lgv[li] + off;
    }
    vsync_l();
    {
      float qo[8], ko[8];
#pragma unroll
      for (int e = 0; e < 8; ++e) {
        const float bv = bb[li4 * 33 + d8 + e];
        qo[e] = q8[e] * 0.17677669529663687f * __expf(bv);
        ko[e] = k8[e] * __expf(-bv);
      }
      u32x4 qw, kw;
      qw.x = pack2(qo[0], qo[1]); qw.y = pack2(qo[2], qo[3]); qw.z = pack2(qo[4], qo[5]); qw.w = pack2(qo[6], qo[7]);
      kw.x = pack2(ko[0], ko[1]); kw.y = pack2(ko[2], ko[3]); kw.z = pack2(ko[4], ko[5]); kw.w = pack2(ko[6], ko[7]);
      *(u32x4*)(QiB + li4 * 40 + d8) = qw;
      *(u32x4*)(KiB + li4 * 40 + d8) = kw;
    }
    vsync_l();
    {
      bf16x8 qf[2];
#pragma unroll
      for (int ks = 0; ks < 2; ++ks) qf[ks] = *(const bf16x8*)(QiB + (it * 32 + r) * 40 + ks * 16 + h * 8);
      f32x16 sT[2];
#pragma unroll
      for (int jt = 0; jt < 2; ++jt) {
#pragma unroll
        for (int i = 0; i < 16; ++i) sT[jt][i] = 0.f;
#pragma unroll
        for (int ks = 0; ks < 2; ++ks) {
          const bf16x8 a = *(const bf16x8*)(KiB + (jt * 32 + r) * 40 + ks * 16 + h * 8);
          sT[jt] = MFMA32(a, qf[ks], sT[jt]);
        }
        const int ti = it * 32 + r;
#pragma unroll
        for (int i = 0; i < 16; ++i) {
          const int tj = jt * 32 + 8 * (i >> 2) + 4 * h + (i & 3);
          const bool keep = (dir == 0) ? (tj <= ti) : (tj >= ti);
          sT[jt][i] = keep ? sT[jt][i] : 0.f;
        }
      }
#pragma unroll
      for (int jt = 0; jt < 2; ++jt)
#pragma unroll
        for (int jj = 0; jj < 2; ++jj) {
          u32x4 pk;
          pk.x = pack2(sT[jt][8 * jj + 0], sT[jt][8 * jj + 1]); pk.y = pack2(sT[jt][8 * jj + 2], sT[jt][8 * jj + 3]);
          pk.z = pack2(sT[jt][8 * jj + 4], sT[jt][8 * jj + 5]); pk.w = pack2(sT[jt][8 * jj + 6], sT[jt][8 * jj + 7]);
          const bf16x8 pf = __builtin_bit_cast(bf16x8, pk);
          const int vsw = (((et * 32 + r) >> 3) & 7) << 3;
          const bfr* vrow = VtB + (et * 32 + r) * 72;
          s16x4 lo = *(const s16x4*)(vrow + ((jt * 32 + 16 * jj + 4 * h) ^ vsw));
          s16x4 hi = *(const s16x4*)(vrow + ((jt * 32 + 16 * jj + 4 * h + 8) ^ vsw));
          bf16x8 vf = __builtin_shufflevector(lo, hi, 0, 1, 2, 3, 4, 5, 6, 7);
          accO = MFMA32(vf, pf, accO);
        }
#pragma unroll
      for (int ks = 0; ks < 2; ++ks) {
        const bf16x8 a = *(const bf16x8*)(StB + (et * 32 + r) * 40 + ks * 16 + h * 8);
        accO = MFMA32(a, qf[ks], accO);
      }
    }
  }
  {
    float ss = 0.f;
#pragma unroll
    for (int i = 0; i < 16; ++i) ss += accO[i] * accO[i];
    ss += __shfl_xor(ss, 32);
    if (h == 0) ssq[w * 32 + r] = ss;
    vsync_l();
    const float tot = ssq[w * 32 + r] + ssq[(w ^ 2) * 32 + r];
    const float rstd = rsqrtf(tot * (1.f / 64.f) + 1e-6f);
    const size_t m = m0 + it * 32 + r;
    const float* ng = p.in[oidx(26)] + l * 64;
#pragma unroll
    for (int g4 = 0; g4 < 4; ++g4) {
      const int e0 = et * 32 + 8 * g4 + 4 * h;
      const uint2 rw = *(const uint2*)(P + m * PW + 2464 + hh * 64 + e0);
      const float rv[4] = {__uint_as_float(rw.x << 16), __uint_as_float(rw.x & 0xffff0000u), __uint_as_float(rw.y << 16), __uint_as_float(rw.y & 0xffff0000u)};
      float ov[4];
#pragma unroll
      for (int q = 0; q < 4; ++q) ov[q] = accO[4 * g4 + q] * rstd * ng[e0 + q] * (rv[q] * __builtin_amdgcn_rcpf(1.f + __expf(-rv[q])));
      uint2 pk; pk.x = pack2(ov[0], ov[1]); pk.y = pack2(ov[2], ov[3]);
      *(uint2*)(O + m * DM + 512 + hh * 64 + e0) = pk;
    }
  }
}

DI void shifted_load8(const bfr* P, int m, int t, int col, const float* mu, float (&o)[8]) {
  const bfr* row = P + (size_t)m * PW + col;
  const bool hp = (t != 0 && t != TL), hn = (t != TL - 1 && t != TT - 1);
  const u32x4 cur = *(const u32x4*)row;
  u32x4 prv = {0u, 0u, 0u, 0u}, nxt = {0u, 0u, 0u, 0u};
  if (hp) prv = *(const u32x4*)(row - PW);
  if (hn) nxt = *(const u32x4*)(row + PW);
  float x[8], xp[8], xn[8], m0v[8], m1v[8];
  unpack8(cur, x); unpack8(prv, xp); unpack8(nxt, xn);
  load8f(mu + col, m0v); load8f(mu + 1152 + col, m1v);
#pragma unroll
  for (int e = 0; e < 8; ++e) o[e] = x[e] + m0v[e] * (xp[e] - x[e]) + m1v[e] * (xn[e] - x[e]);
}

DN void rw_finish_tile(const Params& p, int l, int tile, char* smem) {
  const bfr* P = (const bfr*)(p.ws + OFF_P);
  const bfr* RWIN = (const bfr*)(p.ws + OFF_RWIN);
  const bfr* Y0 = (const bfr*)(p.ws + OFF_RWY);
  const bfr* Y1 = Y0 + (size_t)MR * 256;
  bfr* O = (bfr*)(p.ws + OFF_HO);
  const float* mu = p.in[oidx(10)] + (size_t)l * 2 * 1152;
  const int tid = otid();
  const int c0 = (tid & 31) * 8;
  float lng[8], lnb[8], rk[8], kaw[8];
  load8f(p.in[oidx(19)] + l * 256 + c0, lng); load8f(p.in[oidx(20)] + l * 256 + c0, lnb);
  load8f(p.in[oidx(18)] + l * 256 + c0, rk); load8f(p.in[oidx(17)] + l * 256 + c0, kaw);
#pragma unroll 1
  for (int ps = 0; ps < 2; ++ps) {
    const int m = tile * 16 + ps * 8 + (tid >> 5), t = m % TT;
    float y0[8], y1[8], af[8], ab[8], gt[8], rr[8], kx[8], vx[8];
    unpack8(*(const u32x4*)(Y0 + (size_t)m * 256 + c0), y0);
    unpack8(*(const u32x4*)(Y1 + (size_t)m * 256 + c0), y1);
    unpack8(*(const u32x4*)(RWIN + ((size_t)2 * MR + m) * 256 + c0), af);
    unpack8(*(const u32x4*)(RWIN + ((size_t)3 * MR + m) * 256 + c0), ab);
    unpack8(*(const u32x4*)(RWIN + ((size_t)4 * MR + m) * 256 + c0), gt);
    shifted_load8(P, m, t, c0, mu, rr);
    shifted_load8(P, m, t, 256 + c0, mu, kx);
    shifted_load8(P, m, t, 512 + c0, mu, vx);
    float sy = 0.f;
#pragma unroll
    for (int e = 0; e < 8; ++e) { y0[e] += y1[e]; sy += y0[e]; }
    const float mean = red8(sy) * (1.f / 64.f);
    float sv = 0.f, sd = 0.f;
#pragma unroll
    for (int e = 0; e < 8; ++e) {
      const float dl = y0[e] - mean; y0[e] = dl; sv += dl * dl;
      const float kds = kx[e] * (1.f + (af[e] - 1.f) * kaw[e]) + kx[e] * (1.f + (ab[e] - 1.f) * kaw[e]);
      sd += rr[e] * rk[e] * kds;
    }
    const float var = red8(sv) * (1.f / 64.f);
    const float sdot = red8(sd);
    const float rs = rsqrtf(var + 64e-5f);
    float ov[8];
#pragma unroll
    for (int e = 0; e < 8; ++e) ov[e] = (y0[e] * rs * lng[e] + lnb[e] + sdot * vx[e]) * gt[e];
    u32x4 ow; ow.x = pack2(ov[0], ov[1]); ow.y = pack2(ov[2], ov[3]); ow.z = pack2(ov[4], ov[5]); ow.w = pack2(ov[6], ov[7]);
    *(u32x4*)(O + (size_t)m * DM + c0) = ow;
  }
}

#define GSYNC() do { \
    asm volatile("s_waitcnt vmcnt(0)" ::: "memory");     \
    __syncthreads(); \
    gs_target += gridDim.x; \
    if (threadIdx.x == 0) { \
      unsigned* gbar_ = (unsigned*)(p.ws + OFF_CTR) + 32; \
      __builtin_amdgcn_fence(__ATOMIC_RELEASE, "agent"); \
      __hip_atomic_fetch_add(gbar_, 1u, __ATOMIC_RELAXED, __HIP_MEMORY_SCOPE_AGENT); \
      while ((int)(__hip_atomic_load(gbar_, __ATOMIC_RELAXED, __HIP_MEMORY_SCOPE_AGENT) - gs_target) < 0) __builtin_amdgcn_s_sleep(1); \
      __builtin_amdgcn_fence(__ATOMIC_ACQUIRE, "agent"); \
      asm volatile("s_waitcnt vmcnt(0)" ::: "memory");     \
    } \
    __syncthreads(); \
  } while (0)
#define EXP_G 1
__global__ void __launch_bounds__(512, 2) fwd_megakernel(Params p) {
  cg::grid_group grid = cg::this_grid();
  unsigned gs_target = 0;
  if (threadIdx.x < 8) ((int*)(dynlds + LDS_MISC_OFF))[threadIdx.x] = 0;
  __syncthreads();
#define smem ((char*)dynlds + vhalf() * 65536)
#define s_item ((volatile int*)(dynlds + LDS_MISC_OFF) + 4 + vhalf())
#define ctr ((unsigned*)(p.ws + OFF_CTR))

  convert_weights(p, 0, smem);
  compute_mod(p, smem);
  compute_rope(p);
  if (blockIdx.x == 0 && threadIdx.x < 24) ctr[threadIdx.x] = 0u;
  if (blockIdx.x == 0 && threadIdx.x == 32) ctr[32] = 0u;
  grid.sync();

#pragma unroll 1
  for (int l = 0; l < 2; ++l) {
    const bool need_ctx = (l == 0);
    if (l == 1) convert_weights(p, 1, smem);
#pragma unroll 1
    for (int r2 = 0; r2 < EXP_G; ++r2) {
    norm_phase(p, l, 0, l == 0, false);
    GSYNC();
    phase_g1(p);
    GSYNC();
    }
    phase_prep(p, l, smem);
    GSYNC();
#pragma unroll 1
    for (int r2 = 0; r2 < EXP_G; ++r2) {
    phase_lora(p, l);
    GSYNC();
    }
#ifndef EXP_MIX
#define EXP_MIX 1
#define EXP_MODE 1
#define EXP_TOTAL (n_rw)
#define EXP_FIN 1
#endif
#pragma unroll 1
    for (int rep = 0; rep < EXP_MIX; ++rep) {
      const int n_rw = 128, n_gla = 64, n_da = 512, n_gq = 512;
      const int n_dac = need_ctx ? 64 : 0, n_gqc = need_ctx ? 64 : 0;
      const int total = n_gla + n_da + n_gq + n_dac + n_gqc;
      for (int it = blockIdx.x; it < n_rw; it += gridDim.x) rw_scan_item(p, l, it, need_ctx, rep == 0 ? 0 : EXP_MODE);
      volatile int* s_blk = (volatile int*)(dynlds + LDS_MISC_OFF) + 8;
      const int xcd = (int)(__builtin_amdgcn_s_getreg((3 << 11) | 20) & 7u);
      const int QL = 136 + (need_ctx ? 16 : 0);
      int xo = 0;
      (void)total;
      for (;;) {
        __syncthreads();
        if (threadIdx.x == 0) {
          int got = -1, gq_ = 0;
          while (xo < 8) {
            const int q = (xcd + xo) & 7;
            const int k = (int)atomicAdd(&ctr[8 + l * 8 + q], 1u);
            if (k < QL) { got = k; gq_ = q; break; }
            ++xo;
          }
          s_blk[0] = got; s_blk[1] = gq_;
        }
        __syncthreads();
        int k = s_blk[0];
        const int q = s_blk[1];
        if (k < 0) break;
        if (k < 8) { gla_state_item(p, l, (k * 8 + q) * 2 + vhalf(), smem); continue; }
        k -= 8;
        if (k < 64) { const int g = (k >> 3) * 8 + q, qt = k & 7, b = g >> 2, hd = g & 3; da_item(p, l, b, hd, qt * 256, 0, 36, smem); continue; }
        k -= 64;
        if (k < 64) { const int g = (k >> 4) * 8 + q, sub = k & 15, b = g >> 1, hq = (g & 1) * 2 + (sub >> 3), qt = sub & 7; gqa_item(p, b, hq, qt * 256, 0, 36, smem); continue; }
        k -= 64;
        if (k < 8) { const int e = k * 8 + q, hd = e & 3, b = e >> 2; da_item(p, l, b, hd, TL, TL, 4, smem); continue; }
        k -= 8;
        { const int e = k * 8 + q, hq = e & 3, b = e >> 2; gqa_item(p, b, hq, TL, TL, 4, smem); }
      }
    }
    GSYNC();
#ifndef EXP_FIN
#define EXP_FIN 1
#endif
#pragma unroll 1
    for (int repf = 0; repf < EXP_FIN; ++repf) {
      const int n_rwf = MR / 16;
      const int n_glaf = NB * 36 * 4;
      for (int it = VB(); it < n_rwf + n_glaf; it += NVB()) {
        if (it < n_rwf) {
          int m0 = it * 16;
          if (!need_ctx && (m0 % TT) >= TL) continue;
          rw_finish_tile(p, l, it, smem);
        } else {
          int i2 = it - n_rwf;
          int hh = i2 & 3, cs = (i2 >> 2) % 36, b = (i2 >> 2) / 36;
          if (!need_ctx && cs >= 32) continue;
          gla_finish_item(p, l, b, cs, hh, smem);
        }
      }
    }
    GSYNC();
    phase_resid_gemm(p, l, (const bfr*)(p.ws + OFF_HO), (const bfr*)(p.ws + OFF_WOUT), DM, 2, l == 0, !need_ctx);
    GSYNC();
#pragma unroll 1
    for (int r2 = 0; r2 < EXP_G; ++r2) {
    norm_phase(p, l, 1, false, !need_ctx);
    GSYNC();
    phase_g3(p, l, !need_ctx);
    GSYNC();
    }
    fix_own_tiles(p, l, !need_ctx);
    phase_resid_gemm(p, l, (const bfr*)(p.ws + OFF_A2), (const bfr*)(p.ws + OFF_WDN), DFF, 5, false, !need_ctx);
    GSYNC();
  }
}

extern "C" void kernel_launch(void* const* d_in, const int* in_sizes, int n_in,
                              void* d_out, int out_size, void* d_ws, size_t ws_size,
                              hipStream_t stream) {
  static int grid_blocks = 0;
  if (!grid_blocks) {
    int dev = 0, cus = 0, per_cu = 0;
    (void)hipGetDevice(&dev);
    (void)hipDeviceGetAttribute(&cus, hipDeviceAttributeMultiprocessorCount, dev);
    if (hipFuncSetAttribute((const void*)fwd_megakernel, hipFuncAttributeMaxDynamicSharedMemorySize, LDS_BYTES) != hipSuccess)
      fprintf(stderr, "hipFuncSetAttribute failed\n");
    (void)hipOccupancyMaxActiveBlocksPerMultiprocessor(&per_cu, fwd_megakernel, 512, LDS_BYTES);
    (void)hipGetLastError();
    grid_blocks = cus;
  }
  Params p{};
  for (int i = 0; i < 32; ++i) p.in[i] = (const float*)d_in[i];
  p.out = (float*)d_out;
  p.ws = (char*)d_ws;
  void* args[] = {&p};
  hipError_t e = hipLaunchCooperativeKernel((void*)fwd_megakernel, dim3(grid_blocks), dim3(512), args, LDS_BYTES, stream);
  if (e != hipSuccess) fprintf(stderr, "cooperative launch failed: %s (grid %d)\n", hipGetErrorString(e), grid_blocks);
}
```
